# Optimizing an MI355X kernel written in HIP

```python
import math
import jax, jax.numpy as jnp
from jax import lax
import numpy as np

D_MODEL = 1024
BATCH = 8
SEQ = 2048
DEPTH = 1
DEC_BATCH = 8
DEC_SEQ = 8192
PAST_LEN = 128

D_MIX = D_MODEL
D_S5 = D_MIX // 2
S5_GROUP = 16
S5_GROUPS = D_S5 // S5_GROUP
S5_STATE = 64
D_GMLP = D_MIX - D_S5
GMLP_HEADS = 4
GMLP_HEAD_DIM = D_GMLP // GMLP_HEADS
CHUNK = 128
SCAN_CHUNK = 128
D_FF = ((8 * D_MODEL // 3 + 127) // 128) * 128
N_MOD = 9
EPS = 1e-6

kernel_name = "hymba_s5_gmlp_macaron_adaln_encoder"


def rmsnorm(x, g):
    xf = x.astype(jnp.float32)
    y = xf * lax.rsqrt(jnp.mean(xf * xf, axis=-1, keepdims=True) + EPS)
    return (y * g.astype(jnp.float32)).astype(x.dtype)


def layernorm(x, g, b):
    xf = x.astype(jnp.float32)
    mu = jnp.mean(xf, axis=-1, keepdims=True)
    xc = xf - mu
    y = xc * lax.rsqrt(jnp.mean(xc * xc, axis=-1, keepdims=True) + EPS)
    return (y * g.astype(jnp.float32) + b.astype(jnp.float32)).astype(x.dtype)


def modulate(h, shift, scale):
    return h * (1 + scale[:, None, :]) + shift[:, None, :]


def swiglu(h, w_in, w_out):
    gate, up = jnp.split(h @ w_in, 2, axis=-1)
    return (jax.nn.silu(gate) * up) @ w_out


def s5_discretise(lam_re, lam_im, log_step, b_re, b_im):
    dt = jnp.exp(log_step)[:, None]
    mag = jnp.exp(lam_re * dt)
    ab_re = mag * jnp.cos(lam_im * dt)
    ab_im = mag * jnp.sin(lam_im * dt)
    n_re = ab_re - 1.0
    n_im = ab_im
    den = lam_re * lam_re + lam_im * lam_im
    f_re = (n_re * lam_re + n_im * lam_im) / den
    f_im = (n_im * lam_re - n_re * lam_im) / den
    bb_re = f_re[..., None] * b_re - f_im[..., None] * b_im
    bb_im = f_re[..., None] * b_im + f_im[..., None] * b_re
    return ab_re, ab_im, bb_re, bb_im


def _linear_recurrence_op(left, right):
    a1r, a1i, b1r, b1i = left
    a2r, a2i, b2r, b2i = right
    ar = a2r * a1r - a2i * a1i
    ai = a2r * a1i + a2i * a1r
    br = a2r * b1r - a2i * b1i + b2r
    bi = a2r * b1i + a2i * b1r + b2i
    return ar, ai, br, bi


def s5_scan_direction(u, lam_re, lam_im, log_step, b_re, b_im, c_re, c_im):
    bsz, seq_len, n_groups, _ = u.shape
    n_state = lam_re.shape[-1]
    ab_re, ab_im, bb_re, bb_im = s5_discretise(lam_re, lam_im, log_step, b_re, b_im)
    n_seg = seq_len // SCAN_CHUNK
    u_seg = u.reshape(bsz, n_seg, SCAN_CHUNK, n_groups, S5_GROUP).transpose(1, 0, 2, 3, 4)
    a_re = jnp.broadcast_to(ab_re, (bsz, SCAN_CHUNK, n_groups, n_state))
    a_im = jnp.broadcast_to(ab_im, (bsz, SCAN_CHUNK, n_groups, n_state))

    def step(carry, u_c):
        s_re, s_im = carry
        bu_re = jnp.einsum('gph,btgh->btgp', bb_re, u_c)
        bu_im = jnp.einsum('gph,btgh->btgp', bb_im, u_c)
        cum_re, cum_im, loc_re, loc_im = lax.associative_scan(
            _linear_recurrence_op, (a_re, a_im, bu_re, bu_im), axis=1)
        x_re = loc_re + cum_re * s_re[:, None] - cum_im * s_im[:, None]
        x_im = loc_im + cum_re * s_im[:, None] + cum_im * s_re[:, None]
        y = (jnp.einsum('ghp,btgp->btgh', c_re, x_re)
             - jnp.einsum('ghp,btgp->btgh', c_im, x_im))
        return (x_re[:, -1], x_im[:, -1]), y

    init = (jnp.zeros((bsz, n_groups, n_state), jnp.float32),
            jnp.zeros((bsz, n_groups, n_state), jnp.float32))
    _, ys = lax.scan(step, init, u_seg)
    return ys.transpose(1, 0, 2, 3, 4).reshape(bsz, seq_len, n_groups, S5_GROUP)


def s5_mixer(u, lam_re_f, lam_im_f, log_step_f, b_re_f, b_im_f, c_re_f, c_im_f,
             lam_re_b, lam_im_b, log_step_b, b_re_b, b_im_b, c_re_b, c_im_b, d, w_glu):
    bsz, seq_len, _ = u.shape
    f32 = lambda a: a.astype(jnp.float32)
    uf = f32(u)
    ug = uf.reshape(bsz, seq_len, S5_GROUPS, S5_GROUP)
    y_f = s5_scan_direction(ug, f32(lam_re_f), f32(lam_im_f), f32(log_step_f),
                            f32(b_re_f), f32(b_im_f), f32(c_re_f), f32(c_im_f))
    y_b = s5_scan_direction(ug[:, ::-1], f32(lam_re_b), f32(lam_im_b), f32(log_step_b),
                            f32(b_re_b), f32(b_im_b), f32(c_re_b), f32(c_im_b))[:, ::-1]
    y = (y_f + y_b).reshape(bsz, seq_len, D_S5) + f32(d) * uf
    y = jax.nn.gelu(y).astype(u.dtype)
    return y * jax.nn.sigmoid(y @ w_glu)


def gmlp_mixer(z, ln_g, ln_b, w_sp, b_sp):
    z = jax.nn.gelu(z)
    u, v = jnp.split(z, 2, axis=-1)
    v = layernorm(v, ln_g, ln_b)
    bsz, seq_len, _ = v.shape
    vc = v.reshape(bsz, seq_len // CHUNK, CHUNK, GMLP_HEADS, GMLP_HEAD_DIM)
    mixed = jnp.einsum('hqk,bnkhc->bnqhc', w_sp, vc) + b_sp.T[None, None, :, :, None]
    return u * mixed.reshape(bsz, seq_len, D_GMLP)


def encoder_layer(x, c, w_ada, b_ada, norm_ffn1_g, ffn1_w_in, ffn1_w_out,
                  norm_mix_g, w_mix_in,
                  s5_lam_re_f, s5_lam_im_f, s5_log_step_f, s5_b_re_f, s5_b_im_f, s5_c_re_f, s5_c_im_f,
                  s5_lam_re_b, s5_lam_im_b, s5_log_step_b, s5_b_re_b, s5_b_im_b, s5_c_re_b, s5_c_im_b,
                  s5_d, s5_w_glu, gmlp_ln_g, gmlp_ln_b, gmlp_w_sp, gmlp_b_sp,
                  norm_out_s5_g, norm_out_gmlp_g, w_mix_out,
                  norm_ffn2_g, ffn2_w_in, ffn2_w_out):
    mod = jax.nn.silu(c) @ w_ada + b_ada
    sh1, sc1, g1, sh2, sc2, g2, sh3, sc3, g3 = jnp.split(mod, N_MOD, axis=-1)
    h = modulate(rmsnorm(x, norm_ffn1_g), sh1, sc1)
    x = x + 0.5 * g1[:, None, :] * swiglu(h, ffn1_w_in, ffn1_w_out)
    h = modulate(rmsnorm(x, norm_mix_g), sh2, sc2)
    z = h @ w_mix_in
    y_s5 = s5_mixer(z[..., :D_S5],
                    s5_lam_re_f, s5_lam_im_f, s5_log_step_f, s5_b_re_f, s5_b_im_f, s5_c_re_f, s5_c_im_f,
                    s5_lam_re_b, s5_lam_im_b, s5_log_step_b, s5_b_re_b, s5_b_im_b, s5_c_re_b, s5_c_im_b,
                    s5_d, s5_w_glu)
    y_gm = gmlp_mixer(z[..., D_S5:], gmlp_ln_g, gmlp_ln_b, gmlp_w_sp, gmlp_b_sp)
    y_cat = jnp.concatenate([rmsnorm(y_s5, norm_out_s5_g), rmsnorm(y_gm, norm_out_gmlp_g)], axis=-1)
    x = x + g2[:, None, :] * (y_cat @ w_mix_out)
    h = modulate(rmsnorm(x, norm_ffn2_g), sh3, sc3)
    x = x + 0.5 * g3[:, None, :] * swiglu(h, ffn2_w_in, ffn2_w_out)
    return x


def run_trunk(x, c, layer_params, final_norm_g):
    for l in range(DEPTH):
        x = encoder_layer(x, c, *[p[l] for p in layer_params])
    return rmsnorm(x, final_norm_g)


def setup_inputs(seed: int = 0) -> dict:
    key = jax.random.key(seed)
    ks = iter(jax.random.split(key, 64))
    nrm = lambda shape, s: jax.random.normal(next(ks), shape, jnp.float32) * s
    G, P, H = S5_GROUPS, S5_STATE, S5_GROUP

    def gain(shape):
        return 1.0 + nrm(shape, 0.02)

    def s5_dir():
        lam_re = -0.5 * (1.0 + nrm((DEPTH, G, P), 0.02))
        lam_im = math.pi * jnp.arange(P, dtype=jnp.float32)[None, None, :] + nrm((DEPTH, G, P), 0.01)
        log_step = jax.random.uniform(next(ks), (DEPTH, G), jnp.float32,
                                      math.log(0.001), math.log(0.1))
        b_re = nrm((DEPTH, G, P, H), (2 * H) ** -0.5)
        b_im = nrm((DEPTH, G, P, H), (2 * H) ** -0.5)
        c_re = nrm((DEPTH, G, H, P), (2 * P) ** -0.5)
        c_im = nrm((DEPTH, G, H, P), (2 * P) ** -0.5)
        return lam_re, lam_im, log_step, b_re, b_im, c_re, c_im

    x_prompt = nrm((BATCH, SEQ, D_MODEL), 1.0)
    x_sample = nrm((DEC_BATCH, DEC_SEQ, D_MODEL), 1.0)
    c_prompt = nrm((BATCH, D_MODEL), 1.0)
    c_sample = nrm((DEC_BATCH, D_MODEL), 1.0)
    w_ada = nrm((DEPTH, D_MODEL, N_MOD * D_MODEL), 0.5 * D_MODEL ** -0.5)
    b_ada = nrm((DEPTH, N_MOD * D_MODEL), 0.01)
    norm_ffn1_g = gain((DEPTH, D_MODEL))
    ffn1_w_in = nrm((DEPTH, D_MODEL, 2 * D_FF), D_MODEL ** -0.5)
    ffn1_w_out = nrm((DEPTH, D_FF, D_MODEL), D_FF ** -0.5)
    norm_mix_g = gain((DEPTH, D_MODEL))
    w_mix_in = nrm((DEPTH, D_MODEL, D_S5 + 2 * D_GMLP), D_MODEL ** -0.5)
    lre_f, lim_f, ls_f, bre_f, bim_f, cre_f, cim_f = s5_dir()
    lre_b, lim_b, ls_b, bre_b, bim_b, cre_b, cim_b = s5_dir()
    s5_d = nrm((DEPTH, D_S5), 1.0)
    s5_w_glu = nrm((DEPTH, D_S5, D_S5), D_S5 ** -0.5)
    gmlp_ln_g = gain((DEPTH, D_GMLP))
    gmlp_ln_b = nrm((DEPTH, D_GMLP), 0.01)
    gmlp_w_sp = nrm((DEPTH, GMLP_HEADS, CHUNK, CHUNK), CHUNK ** -0.5)
    gmlp_b_sp = 1.0 + nrm((DEPTH, GMLP_HEADS, CHUNK), 0.01)
    norm_out_s5_g = gain((DEPTH, D_S5))
    norm_out_gmlp_g = gain((DEPTH, D_GMLP))
    w_mix_out = nrm((DEPTH, D_MIX, D_MODEL), D_MIX ** -0.5)
    norm_ffn2_g = gain((DEPTH, D_MODEL))
    ffn2_w_in = nrm((DEPTH, D_MODEL, 2 * D_FF), D_MODEL ** -0.5)
    ffn2_w_out = nrm((DEPTH, D_FF, D_MODEL), D_FF ** -0.5)
    final_norm_g = gain((D_MODEL,))
    return {
        "x_prompt": x_prompt, "x_sample": x_sample,
        "c_prompt": c_prompt, "c_sample": c_sample,
        "w_ada": w_ada, "b_ada": b_ada,
        "norm_ffn1_g": norm_ffn1_g, "ffn1_w_in": ffn1_w_in, "ffn1_w_out": ffn1_w_out,
        "norm_mix_g": norm_mix_g, "w_mix_in": w_mix_in,
        "s5_lam_re_f": lre_f, "s5_lam_im_f": lim_f, "s5_log_step_f": ls_f,
        "s5_b_re_f": bre_f, "s5_b_im_f": bim_f, "s5_c_re_f": cre_f, "s5_c_im_f": cim_f,
        "s5_lam_re_b": lre_b, "s5_lam_im_b": lim_b, "s5_log_step_b": ls_b,
        "s5_b_re_b": bre_b, "s5_b_im_b": bim_b, "s5_c_re_b": cre_b, "s5_c_im_b": cim_b,
        "s5_d": s5_d, "s5_w_glu": s5_w_glu,
        "gmlp_ln_g": gmlp_ln_g, "gmlp_ln_b": gmlp_ln_b,
        "gmlp_w_sp": gmlp_w_sp, "gmlp_b_sp": gmlp_b_sp,
        "norm_out_s5_g": norm_out_s5_g, "norm_out_gmlp_g": norm_out_gmlp_g,
        "w_mix_out": w_mix_out,
        "norm_ffn2_g": norm_ffn2_g, "ffn2_w_in": ffn2_w_in, "ffn2_w_out": ffn2_w_out,
        "final_norm_g": final_norm_g,
    }


def reference(x_prompt, x_sample, c_prompt, c_sample, w_ada, b_ada,
              norm_ffn1_g, ffn1_w_in, ffn1_w_out, norm_mix_g, w_mix_in,
              s5_lam_re_f, s5_lam_im_f, s5_log_step_f, s5_b_re_f, s5_b_im_f, s5_c_re_f, s5_c_im_f,
              s5_lam_re_b, s5_lam_im_b, s5_log_step_b, s5_b_re_b, s5_b_im_b, s5_c_re_b, s5_c_im_b,
              s5_d, s5_w_glu, gmlp_ln_g, gmlp_ln_b, gmlp_w_sp, gmlp_b_sp,
              norm_out_s5_g, norm_out_gmlp_g, w_mix_out,
              norm_ffn2_g, ffn2_w_in, ffn2_w_out, final_norm_g):
    layer_params = (w_ada, b_ada, norm_ffn1_g, ffn1_w_in, ffn1_w_out, norm_mix_g, w_mix_in,
                    s5_lam_re_f, s5_lam_im_f, s5_log_step_f, s5_b_re_f, s5_b_im_f, s5_c_re_f, s5_c_im_f,
                    s5_lam_re_b, s5_lam_im_b, s5_log_step_b, s5_b_re_b, s5_b_im_b, s5_c_re_b, s5_c_im_b,
                    s5_d, s5_w_glu, gmlp_ln_g, gmlp_ln_b, gmlp_w_sp, gmlp_b_sp,
                    norm_out_s5_g, norm_out_gmlp_g, w_mix_out,
                    norm_ffn2_g, ffn2_w_in, ffn2_w_out)
    y_prompt = run_trunk(x_prompt, c_prompt, layer_params, final_norm_g)
    y_sample = run_trunk(x_sample, c_sample, layer_params, final_norm_g)
    return (y_prompt, y_sample)
```

```cpp
#include <hip/hip_runtime.h>
#include <hip/hip_cooperative_groups.h>
#include <cstdio>
namespace cg = cooperative_groups;

#define LAS __attribute__((address_space(3)))
typedef unsigned short bf16_t;
typedef short bf16x8 __attribute__((ext_vector_type(8)));
typedef float f32x4 __attribute__((ext_vector_type(4)));
typedef unsigned u32x4 __attribute__((ext_vector_type(4)));
typedef unsigned u32x2 __attribute__((ext_vector_type(2)));

#ifndef N_LAUNCH_MODE
#define N_LAUNCH_MODE 0
#endif

constexpr int MT = 81920;
constexpr int MP = 16384;
constexpr int DM = 1024, DFF = 2816, NIN = 5632, NMIX = 1536;
constexpr int NGRP = 32, TCH = 32, NCHK = MT / TCH  , KS2 = 768;
constexpr float EPS = 1e-6f;
constexpr int NPHASE = 16;

constexpr size_t al256(size_t x) { return (x + 255) & ~(size_t)255; }
constexpr size_t WS_MOD = 0;
constexpr size_t MOD_BYTES = 16 * 9216 * 4;
constexpr size_t WS_WIN1 = al256(WS_MOD + MOD_BYTES);
constexpr size_t WS_WIN2 = WS_WIN1 + (size_t)NIN * DM * 2;
constexpr size_t WS_WOUT1 = WS_WIN2 + (size_t)NIN * DM * 2;
constexpr size_t WS_WOUT2 = WS_WOUT1 + (size_t)DM * DFF * 2;
constexpr size_t WS_WMIXIN = WS_WOUT2 + (size_t)DM * DFF * 2;
constexpr size_t WS_WGLU = WS_WMIXIN + (size_t)NMIX * DM * 2;
constexpr size_t WS_WMIXOUT = WS_WGLU + 512 * 512 * 2;
constexpr size_t WS_WBD = WS_WMIXOUT + (size_t)DM * DM * 2;
constexpr size_t WS_KLAG = WS_WBD + 512 * 512 * 2;
constexpr size_t WS_W1S = WS_KLAG + (size_t)NGRP * 63 * 256 * 4;
constexpr size_t WS_W2S = WS_W1S + (size_t)NGRP * 256 * 512 * 2;
constexpr size_t WS_H = WS_W2S + (size_t)NGRP * 512 * KS2 * 2;
constexpr size_t WS_R = WS_H + (size_t)MT * DM * 2;
constexpr size_t WS_HID = WS_R;
constexpr size_t WS_UG = WS_R;
constexpr size_t WS_UGM = WS_UG + (size_t)NGRP * NCHK * KS2 * 2;
constexpr size_t WS_VG = WS_UGM + (size_t)MT * 512 * 2;
constexpr size_t WS_VT = WS_VG + (size_t)MT * 512 * 2;
constexpr size_t WS_SLOC = WS_VT + (size_t)MT * 512 * 2;
constexpr size_t WS_END = WS_R + (size_t)MT * DFF * 2;
static_assert(WS_SLOC + (size_t)NGRP * NCHK * 256 * 4 <= WS_END, "mixer buffers must fit the HID region");

constexpr int LDS_BYTES = 131072;

struct P { const float* in[38]; float* out; unsigned char* ws; int ph_lo, ph_hi; };

__device__ __forceinline__ unsigned cvt_pk_bf16(float lo, float hi) { unsigned r; asm volatile("v_cvt_pk_bf16_f32 %0, %1, %2" : "=v"(r) : "v"(lo), "v"(hi)); return r; }
__device__ __forceinline__ bf16_t f2bf(float f) { return (bf16_t)(cvt_pk_bf16(f, 0.f) & 0xffffu); }
__device__ __forceinline__ float bflo(unsigned w) { return __uint_as_float(w << 16); }
__device__ __forceinline__ float bfhi(unsigned w) { return __uint_as_float(w & 0xffff0000u); }
__device__ __forceinline__ float wave_sum(float v) {
#pragma unroll
    for (int o = 32; o; o >>= 1) v += __shfl_xor(v, o);
    return v;
}
__device__ __forceinline__ float sigmoid_f(float a) { return __builtin_amdgcn_rcpf(1.f + __expf(-a)); }
__device__ __forceinline__ float gelu_f(float x) { return x * sigmoid_f(1.5957691216f * (x + 0.044715f * x * x * x)); }
__device__ __forceinline__ float silu_f(float x) { return x * sigmoid_f(x); }
__device__ __forceinline__ int batch_of_row(int row) { return row < MP ? (row >> 11) : 8 + ((row - MP) >> 13); }
__device__ __forceinline__ int batch_of_tile(int pm) { return pm < 64 ? (pm >> 3) : 8 + ((pm - 64) >> 5); }

namespace pg8 {
constexpr int BM = 256, BK = 64, HALF = 128, HTB = HALF * BK * 2, NXCD = 8, WGM = 8;
__device__ __forceinline__ int lds_byte(int r, int c) { const int st = (r >> 4) * 2 + (c >> 5), rr = r & 15, cc = c & 31, ob = rr * 64 + cc * 2; return st * 1024 + (ob ^ (((ob >> 9) & 1) << 5)); }
__device__ __forceinline__ void stage_rc(int b, int& R, int& C) { const int st = b / 1024, sb = b % 1024, swz = sb ^ (((sb >> 9) & 1) << 5); R = (st >> 1) * 16 + swz / 64; C = (st & 1) * 32 + (swz % 64) / 2; }
__device__ __forceinline__ int perm32(int rho) { const int n = rho >> 4, i = rho & 15; return 8 * (i >> 2) + 4 * n + (i & 3); }

struct Unit { int pm, pn, g; };
struct Gemm { const bf16_t* A; const bf16_t* Bt; int lda, ldb, K; size_t gsA, gsB; };
struct Order {
    int nM, nN, ntot, G, c;
    __device__ void init(int nM_, int nN_, int nG_, int G_, int c_) { nM = nM_; nN = nN_; ntot = nM_ * nN_ * nG_; G = G_; c = c_; }
    __device__ bool next(int i, Unit& u) const {
        const long L = (long)i * G + c; if (L >= ntot) return false;
        int wgid = (int)L; { const int q = ntot / NXCD, r = ntot % NXCD, xcd = wgid % NXCD, off = wgid / NXCD; wgid = (xcd < r ? xcd * (q + 1) : r * (q + 1) + (xcd - r) * q) + off; }
        const int per = nM * nN; u.g = wgid / per; const int w = wgid - u.g * per;
        const int nig = WGM * nN, gid = w / nig, fm = gid * WGM, gsz = (nM - fm) < WGM ? (nM - fm) : WGM;
        u.pm = fm + ((w % nig) % gsz); u.pn = (w % nig) / gsz; return true;
    }
};

template <class Epi>
__device__ __forceinline__ void gemm_phase(LAS unsigned char* lds, const Gemm g, const Order& S, const Epi& E) {
    const int tid = threadIdx.x, wid = __builtin_amdgcn_readfirstlane(tid >> 6), lane = tid & 63, wr = wid >> 2, wc = wid & 3, fr = lane & 15, fq = lane >> 4;
    const int K = g.K, nt = K / BK;
    unsigned voffA[2], voffB[2];
#pragma unroll
    for (int i = 0; i < 2; ++i) { int R, C; stage_rc(tid * 16 + i * 8192, R, C); const int Rb = Epi::PERM ? ((R & ~31) + perm32(R & 31)) : R;
        voffA[i] = (unsigned)(R * g.lda + C) * 2u; voffB[i] = (unsigned)(Rb * g.ldb + C) * 2u; }
    const size_t kstep = (size_t)(BK * 2);
    const size_t hstepA = (size_t)HALF * g.lda * 2, hstepB = (size_t)HALF * g.ldb * 2;
    const size_t tstepA = 2 * hstepA, tstepB = 2 * hstepB;
    const unsigned ldsw = (unsigned)wid * 1024u;
    const int aoff = lds_byte(wr * 64 + fr, fq * 8), boff = lds_byte(wc * 32 + fr, fq * 8);
#define PG8_SA(b, h) (((b) * 2 + (h)) * HTB)
#define PG8_SB(b, h) ((4 + (b) * 2 + (h)) * HTB)
#define PG8_STAGE(bufoff, gbase, voff) do { _Pragma("unroll") for (int _i = 0; _i < 2; ++_i) \
        __builtin_amdgcn_global_load_lds((const unsigned*)((const char*)(gbase) + (voff)[_i]), (LAS unsigned*)(lds + (bufoff) + ldsw + _i * 8192), 16, 0, 0); } while (0)
#define PG8_LDA(dst, b, h) do { _Pragma("unroll") for (int m = 0; m < 4; ++m) _Pragma("unroll") for (int k = 0; k < 2; ++k) dst[m][k] = *(const LAS bf16x8*)(lds + PG8_SA(b, h) + aoff + m * 2048 + k * 1024); } while (0)
#define PG8_LDB(dst, b, h) do { _Pragma("unroll") for (int n = 0; n < 2; ++n) _Pragma("unroll") for (int k = 0; k < 2; ++k) dst[n][k] = *(const LAS bf16x8*)(lds + PG8_SB(b, h) + boff + n * 2048 + k * 1024); } while (0)
#define PG8_MMA(ai, bj, At, Bt) do { __builtin_amdgcn_s_setprio(1); _Pragma("unroll") for (int m = 0; m < 4; ++m) _Pragma("unroll") for (int n = 0; n < 2; ++n) _Pragma("unroll") for (int k = 0; k < 2; ++k) \
        acc[ai][bj][m][n] = __builtin_amdgcn_mfma_f32_16x16x32_bf16(Bt[n][k], At[m][k], acc[ai][bj][m][n], 0, 0, 0); __builtin_amdgcn_s_setprio(0); } while (0)
#define PG8_WAIT_V(n) asm volatile("s_waitcnt vmcnt(" #n ")" ::: "memory")
#define PG8_WAIT_L(n) asm volatile("s_waitcnt lgkmcnt(" #n ")" ::: "memory")
#define PG8_BAR __builtin_amdgcn_s_barrier()
#define PG8_SCHED __builtin_amdgcn_sched_barrier(0)
#define PG8_BASEA(u) ((const char*)g.A + ((size_t)(u).g * g.gsA) * 2 + (size_t)(u).pm * tstepA)
#define PG8_BASEB(u) ((const char*)g.Bt + ((size_t)(u).g * g.gsB) * 2 + (size_t)(u).pn * tstepB)
    Unit cur, nxt; int ui = 0;
    if (!S.next(0, cur)) return;
    f32x4 acc[2][2][4][2];
#pragma unroll
    for (int a = 0; a < 2; ++a)
#pragma unroll
        for (int b = 0; b < 2; ++b)
#pragma unroll
            for (int m = 0; m < 4; ++m)
#pragma unroll
                for (int n = 0; n < 2; ++n) acc[a][b][m][n] = (f32x4){0.f, 0.f, 0.f, 0.f};
    bf16x8 At[4][2], B0[2][2], B1[2][2];
    const char* cA = PG8_BASEA(cur); const char* cB = PG8_BASEB(cur);
    PG8_STAGE(PG8_SB(0, 0), cB, voffB); PG8_STAGE(PG8_SA(0, 0), cA, voffA); PG8_STAGE(PG8_SB(0, 1), cB + hstepB, voffB); PG8_STAGE(PG8_SA(0, 1), cA + hstepA, voffA);
    if (wr == 1) PG8_BAR;
    PG8_WAIT_V(4); PG8_BAR;
    PG8_STAGE(PG8_SB(1, 0), cB + kstep, voffB); PG8_STAGE(PG8_SA(1, 0), cA + kstep, voffA); PG8_STAGE(PG8_SB(1, 1), cB + hstepB + kstep, voffB);
    PG8_WAIT_V(6); PG8_BAR;
    for (;;) {
        const bool has_next = S.next(ui + 1, nxt);
        const char* nA = has_next ? PG8_BASEA(nxt) : cA; const char* nB = has_next ? PG8_BASEB(nxt) : cB;
        for (int t = 0; t < nt; t += 2) {
            const bool last = (t == nt - 2);
            const char* a1 = cA + (size_t)(t + 1) * kstep;
            const char* a2 = last ? nA : cA + (size_t)(t + 2) * kstep; const char* b2 = last ? nB : cB + (size_t)(t + 2) * kstep;
            const char* a3 = a2 + kstep; const char* b3 = b2 + kstep;
            PG8_LDB(B0, 0, 0); PG8_SCHED; PG8_LDA(At, 0, 0); PG8_STAGE(PG8_SA(1, 1), a1 + hstepA, voffA);
            PG8_WAIT_L(8); PG8_BAR; PG8_WAIT_L(0); PG8_MMA(0, 0, At, B0); PG8_BAR; PG8_SCHED;
            PG8_LDB(B1, 0, 1); PG8_STAGE(PG8_SB(0, 0), b2, voffB);
            PG8_BAR; PG8_WAIT_L(0); PG8_MMA(0, 1, At, B1); PG8_BAR;
            PG8_LDA(At, 0, 1); PG8_STAGE(PG8_SA(0, 0), a2, voffA);
            PG8_BAR; PG8_WAIT_L(0); PG8_MMA(1, 0, At, B0); PG8_BAR; PG8_SCHED;
            PG8_STAGE(PG8_SB(0, 1), b2 + hstepB, voffB);
            PG8_WAIT_V(6); PG8_BAR; PG8_MMA(1, 1, At, B1); PG8_BAR;
            PG8_LDB(B0, 1, 0); PG8_SCHED; PG8_LDA(At, 1, 0); PG8_STAGE(PG8_SA(0, 1), a2 + hstepA, voffA);
            PG8_WAIT_L(8); PG8_BAR; PG8_WAIT_L(0); PG8_MMA(0, 0, At, B0); PG8_BAR; PG8_SCHED;
            PG8_LDB(B1, 1, 1); PG8_STAGE(PG8_SB(1, 0), b3, voffB);
            PG8_BAR; PG8_WAIT_L(0); PG8_MMA(0, 1, At, B1); PG8_BAR;
            PG8_LDA(At, 1, 1); PG8_STAGE(PG8_SA(1, 0), a3, voffA);
            PG8_BAR; PG8_WAIT_L(0); PG8_MMA(1, 0, At, B0); PG8_BAR; PG8_SCHED;
            PG8_STAGE(PG8_SB(1, 1), b3 + hstepB, voffB);
            PG8_WAIT_V(6); PG8_BAR; PG8_MMA(1, 1, At, B1); PG8_BAR;
        }
        E(acc, cur, wr, wc, fr, fq);
        if (!has_next) break;
#pragma unroll
        for (int a = 0; a < 2; ++a)
#pragma unroll
            for (int b = 0; b < 2; ++b)
#pragma unroll
                for (int m = 0; m < 4; ++m)
#pragma unroll
                    for (int n = 0; n < 2; ++n) acc[a][b][m][n] = (f32x4){0.f, 0.f, 0.f, 0.f};
        cur = nxt; cA = nA; cB = nB; ++ui;
    }
    PG8_WAIT_V(0);
    if (wr == 0) PG8_BAR;
    PG8_BAR;
#undef PG8_SA
#undef PG8_SB
#undef PG8_STAGE
#undef PG8_LDA
#undef PG8_LDB
#undef PG8_MMA
#undef PG8_WAIT_V
#undef PG8_WAIT_L
#undef PG8_BAR
#undef PG8_SCHED
#undef PG8_BASEA
#undef PG8_BASEB
}
}
using pg8::Unit;
typedef const f32x4 (&AccRef)[2][2][4][2];

struct EpiSwiglu {
    static constexpr bool PERM = true;
    bf16_t* hid;
    __device__ __forceinline__ void operator()(AccRef acc, const Unit& u, int wr, int wc, int fr, int fq) const {
        const int row0 = u.pm * 256 + wr * 64 + fr, col0 = u.pn * 128 + wc * 32 + 8 * fq;
#pragma unroll
        for (int ai = 0; ai < 2; ++ai)
#pragma unroll
            for (int m = 0; m < 4; ++m) {
                const f32x4 g0 = acc[ai][0][m][0], g1 = acc[ai][0][m][1], u0 = acc[ai][1][m][0], u1 = acc[ai][1][m][1];
                u32x4 w;
                w.x = cvt_pk_bf16(silu_f(g0[0]) * u0[0], silu_f(g0[1]) * u0[1]); w.y = cvt_pk_bf16(silu_f(g0[2]) * u0[2], silu_f(g0[3]) * u0[3]);
                w.z = cvt_pk_bf16(silu_f(g1[0]) * u1[0], silu_f(g1[1]) * u1[1]); w.w = cvt_pk_bf16(silu_f(g1[2]) * u1[2], silu_f(g1[3]) * u1[3]);
                *(u32x4*)(hid + (size_t)(row0 + ai * 128 + m * 16) * DFF + col0) = w;
            }
    }
};
struct EpiResid {
    static constexpr bool PERM = false;
    const float* srcP; const float* srcS; float* dst; const float* gate; float scale;
    __device__ __forceinline__ void operator()(AccRef acc, const Unit& u, int wr, int wc, int fr, int fq) const {
        const int row0 = u.pm * 256 + wr * 64 + fr, col0 = u.pn * 256 + wc * 32 + 4 * fq;
        const float* gp = gate + (size_t)batch_of_tile(u.pm) * 9216 + col0;
        f32x4 gv[2][2];
#pragma unroll
        for (int bj = 0; bj < 2; ++bj)
#pragma unroll
            for (int n = 0; n < 2; ++n) gv[bj][n] = *(const f32x4*)(gp + bj * 128 + n * 16) * scale;
        const float* src = u.pm < 64 ? srcP : srcS - (size_t)MP * DM;
#pragma unroll
        for (int ai = 0; ai < 2; ++ai)
#pragma unroll
            for (int m = 0; m < 4; ++m) {
                const size_t off = (size_t)(row0 + ai * 128 + m * 16) * DM + col0;
#pragma unroll
                for (int bj = 0; bj < 2; ++bj)
#pragma unroll
                    for (int n = 0; n < 2; ++n) { const f32x4 bs = *(const f32x4*)(src + off + bj * 128 + n * 16); *(f32x4*)(dst + off + bj * 128 + n * 16) = bs + gv[bj][n] * acc[ai][bj][m][n]; }
                asm volatile("" ::: "memory");
            }
    }
};
struct EpiMixIn {
    static constexpr bool PERM = true;
    bf16_t* ug; bf16_t* ugm; bf16_t* vg;
    __device__ __forceinline__ void operator()(AccRef acc, const Unit& u, int wr, int wc, int fr, int fq) const {
        const int row0 = u.pm * 256 + wr * 64 + fr, colt = wc * 32 + 8 * fq;
        if (u.pn < 2) {
#pragma unroll
            for (int ai = 0; ai < 2; ++ai)
#pragma unroll
                for (int m = 0; m < 4; ++m) { const int row = row0 + ai * 128 + m * 16;
#pragma unroll
                    for (int bj = 0; bj < 2; ++bj) { const int c = u.pn * 256 + bj * 128 + colt; const f32x4 v0 = acc[ai][bj][m][0], v1 = acc[ai][bj][m][1];
                        u32x4 w; w.x = cvt_pk_bf16(v0[0], v0[1]); w.y = cvt_pk_bf16(v0[2], v0[3]); w.z = cvt_pk_bf16(v1[0], v1[1]); w.w = cvt_pk_bf16(v1[2], v1[3]);
                        *(u32x4*)(ug + ((size_t)(c >> 4) * NCHK + (row >> 5)) * KS2 + (row & 31) * 16 + (c & 15)) = w; } }
        } else {
            bf16_t* o = (u.pn < 4 ? ugm : vg) + (u.pn & 1) * 256 + colt;
#pragma unroll
            for (int ai = 0; ai < 2; ++ai)
#pragma unroll
                for (int m = 0; m < 4; ++m) { const int row = row0 + ai * 128 + m * 16;
#pragma unroll
                    for (int bj = 0; bj < 2; ++bj) { const f32x4 v0 = acc[ai][bj][m][0], v1 = acc[ai][bj][m][1];
                        u32x4 w; w.x = cvt_pk_bf16(gelu_f(v0[0]), gelu_f(v0[1])); w.y = cvt_pk_bf16(gelu_f(v0[2]), gelu_f(v0[3])); w.z = cvt_pk_bf16(gelu_f(v1[0]), gelu_f(v1[1])); w.w = cvt_pk_bf16(gelu_f(v1[2]), gelu_f(v1[3]));
                        *(u32x4*)(o + (size_t)row * 512 + bj * 128) = w; } }
        }
    }
};
struct EpiS1 {
    static constexpr bool PERM = false;
    float* sloc;
    __device__ __forceinline__ void operator()(AccRef acc, const Unit& u, int wr, int wc, int fr, int fq) const {
        const int row0 = u.pm * 256 + wr * 64 + fr, col0 = wc * 32 + 4 * fq;
#pragma unroll
        for (int ai = 0; ai < 2; ++ai)
#pragma unroll
            for (int m = 0; m < 4; ++m) { float* rp = sloc + ((size_t)u.g * NCHK + row0 + ai * 128 + m * 16) * 256 + col0;
#pragma unroll
                for (int bj = 0; bj < 2; ++bj)
#pragma unroll
                    for (int n = 0; n < 2; ++n) *(f32x4*)(rp + bj * 128 + n * 16) = acc[ai][bj][m][n]; }
    }
};
struct EpiS2 {
    static constexpr bool PERM = true;
    bf16_t* y;
    __device__ __forceinline__ void operator()(AccRef acc, const Unit& u, int wr, int wc, int fr, int fq) const {
        const int row0 = u.pm * 256 + wr * 64 + fr, colt = u.pn * 256 + wc * 32 + 8 * fq;
#pragma unroll
        for (int ai = 0; ai < 2; ++ai)
#pragma unroll
            for (int m = 0; m < 4; ++m) { const int chunk = row0 + ai * 128 + m * 16;
#pragma unroll
                for (int bj = 0; bj < 2; ++bj) { const int c = colt + bj * 128; const f32x4 v0 = acc[ai][bj][m][0], v1 = acc[ai][bj][m][1];
                    u32x4 w; w.x = cvt_pk_bf16(gelu_f(v0[0]), gelu_f(v0[1])); w.y = cvt_pk_bf16(gelu_f(v0[2]), gelu_f(v0[3])); w.z = cvt_pk_bf16(gelu_f(v1[0]), gelu_f(v1[1])); w.w = cvt_pk_bf16(gelu_f(v1[2]), gelu_f(v1[3]));
                    *(u32x4*)(y + ((size_t)chunk * 32 + (c >> 4)) * 512 + u.g * 16 + (c & 15)) = w; } }
    }
};
struct EpiGlu {
    static constexpr bool PERM = true;
    const bf16_t* y; bf16_t* yg;
    __device__ __forceinline__ void operator()(AccRef acc, const Unit& u, int wr, int wc, int fr, int fq) const {
        const int row0 = u.pm * 256 + wr * 64 + fr, col0 = u.pn * 256 + wc * 32 + 8 * fq;
#pragma unroll
        for (int ai = 0; ai < 2; ++ai)
#pragma unroll
            for (int m = 0; m < 4; ++m) { const size_t off = (size_t)(row0 + ai * 128 + m * 16) * 512 + col0;
#pragma unroll
                for (int bj = 0; bj < 2; ++bj) { const u32x4 yv = *(const u32x4*)(y + off + bj * 128); const f32x4 v0 = acc[ai][bj][m][0], v1 = acc[ai][bj][m][1];
                    u32x4 w; w.x = cvt_pk_bf16(bflo(yv.x) * sigmoid_f(v0[0]), bfhi(yv.x) * sigmoid_f(v0[1])); w.y = cvt_pk_bf16(bflo(yv.y) * sigmoid_f(v0[2]), bfhi(yv.y) * sigmoid_f(v0[3]));
                    w.z = cvt_pk_bf16(bflo(yv.z) * sigmoid_f(v1[0]), bfhi(yv.z) * sigmoid_f(v1[1])); w.w = cvt_pk_bf16(bflo(yv.w) * sigmoid_f(v1[2]), bfhi(yv.w) * sigmoid_f(v1[3]));
                    *(u32x4*)(yg + off + bj * 128) = w; }
                asm volatile("" ::: "memory"); }
    }
};
struct EpiSpatial {
    static constexpr bool PERM = true;
    bf16_t* ugm; const float* bsp;
    __device__ __forceinline__ void operator()(AccRef acc, const Unit& u, int wr, int wc, int fr, int fq) const {
        const int row0 = u.pm * 256 + wr * 64 + fr, col0 = u.pn * 256 + wc * 32 + 8 * fq;
#pragma unroll
        for (int ai = 0; ai < 2; ++ai)
#pragma unroll
            for (int m = 0; m < 4; ++m) { const int r = row0 + ai * 128 + m * 16, h = r >> 7, q = r & 127; const float b = bsp[r];
#pragma unroll
                for (int bj = 0; bj < 2; ++bj) { const int c = col0 + bj * 128, bn = c >> 7, cc = c & 127;
                    bf16_t* ptr = ugm + ((size_t)bn * 128 + q) * 512 + h * 128 + cc;
                    const u32x4 uv = *(const u32x4*)ptr; const f32x4 v0 = acc[ai][bj][m][0], v1 = acc[ai][bj][m][1];
                    u32x4 w; w.x = cvt_pk_bf16(bflo(uv.x) * (v0[0] + b), bfhi(uv.x) * (v0[1] + b)); w.y = cvt_pk_bf16(bflo(uv.y) * (v0[2] + b), bfhi(uv.y) * (v0[3] + b));
                    w.z = cvt_pk_bf16(bflo(uv.z) * (v1[0] + b), bfhi(uv.z) * (v1[1] + b)); w.w = cvt_pk_bf16(bflo(uv.w) * (v1[2] + b), bfhi(uv.w) * (v1[3] + b));
                    *(u32x4*)ptr = w; }
                asm volatile("" ::: "memory"); }
    }
};

__device__ __forceinline__ void transpose_job(LAS unsigned char* lds, const float* src, int Kd, int Nd, bf16_t* dst, int mode) {
    LAS bf16_t* T = (LAS bf16_t*)lds;
    const int tid = threadIdx.x, nkt = Kd / 64, nnt = Nd / 64, ntile = nkt * nnt;
    for (int it = blockIdx.x; it < ntile; it += gridDim.x) {
        const int kt = it % nkt, ntl = it / nkt, k0 = kt * 64, n0 = ntl * 64;
        int n0d = n0;
        if (mode == 1) { const int j = n0 < DFF ? n0 : n0 - DFF; n0d = (j >> 7) * 256 + (j & 127) + (n0 < DFF ? 0 : 128); }
        __syncthreads();
#pragma unroll
        for (int i = 0; i < 8; ++i) { const int e = tid + i * 512, kl = e >> 6, nl = e & 63; T[nl * 66 + kl] = f2bf(src[(size_t)(k0 + kl) * Nd + n0 + nl]); }
        __syncthreads();
#pragma unroll
        for (int i = 0; i < 4; ++i) { const int e = tid + i * 512, nl = e >> 5, kp = e & 31; *(unsigned*)(dst + (size_t)(n0d + nl) * Kd + k0 + 2 * kp) = *(const LAS unsigned*)(T + nl * 66 + 2 * kp); }
    }
    __syncthreads();
}
__device__ __forceinline__ void s5_pow(float lre, float lim, double dt, int tau, double& er, double& ei) {
    const double m = exp((double)lre * dt * (double)tau), a = (double)lim * dt * (double)tau; double s, c; sincos(a, &s, &c); er = m * c; ei = m * s;
}
__device__ __forceinline__ void s5_f(float lre, float lim, double dt, double& fr, double& fi) {
    double ar, ai; s5_pow(lre, lim, dt, 1, ar, ai); const double nr = ar - 1.0, ni = ai, lr = (double)lre, li = (double)lim, den = lr * lr + li * li;
    fr = (nr * lr + ni * li) / den; fi = (ni * lr - nr * li) / den;
}

__device__ __forceinline__ void phase0(const P& p, LAS unsigned char* lds) {
    const int tid = threadIdx.x, G = gridDim.x, bid = blockIdx.x;
    unsigned char* ws = p.ws;
    {
        LAS float* S = (LAS float*)lds;
        float* MOD = (float*)(ws + WS_MOD);
        const float* wada = p.in[4]; const float* bada = p.in[5];
        for (int it = bid; it < 576; it += G) {
            const int cb = it % 36, kc = it / 36;
            __syncthreads();
            for (int e = tid; e < 1024; e += 512) { const int b = e >> 6, k = e & 63; const float* c = b < 8 ? p.in[2] + b * 1024 : p.in[3] + (b - 8) * 1024; const float v = c[kc * 64 + k]; S[e] = silu_f(v); }
            __syncthreads();
            const int col = cb * 256 + (tid & 255), kh = tid >> 8;
            float acc[16];
#pragma unroll
            for (int b = 0; b < 16; ++b) acc[b] = 0.f;
#pragma unroll 8
            for (int kk = 0; kk < 32; ++kk) { const int k = kh * 32 + kk; const float w = wada[(size_t)(kc * 64 + k) * 9216 + col];
#pragma unroll
                for (int b = 0; b < 16; ++b) acc[b] += S[b * 64 + k] * w; }
            if (kc == 0 && kh == 0) { const float bb = bada[col];
#pragma unroll
                for (int b = 0; b < 16; ++b) acc[b] += bb; }
#pragma unroll
            for (int b = 0; b < 16; ++b) unsafeAtomicAdd(MOD + b * 9216 + col, acc[b]);
        }
        __syncthreads();
    }
    transpose_job(lds, p.in[7], DM, NIN, (bf16_t*)(ws + WS_WIN1), 1);
    transpose_job(lds, p.in[35], DM, NIN, (bf16_t*)(ws + WS_WIN2), 1);
    transpose_job(lds, p.in[8], DFF, DM, (bf16_t*)(ws + WS_WOUT1), 0);
    transpose_job(lds, p.in[36], DFF, DM, (bf16_t*)(ws + WS_WOUT2), 0);
    transpose_job(lds, p.in[10], DM, NMIX, (bf16_t*)(ws + WS_WMIXIN), 0);
    transpose_job(lds, p.in[26], 512, 512, (bf16_t*)(ws + WS_WGLU), 0);
    transpose_job(lds, p.in[33], DM, DM, (bf16_t*)(ws + WS_WMIXOUT), 0);
    {
        bf16_t* wbd = (bf16_t*)(ws + WS_WBD); const float* wsp = p.in[29];
        for (int i = bid * 512 + tid; i < 512 * 64; i += G * 512) {
            const int kg = i & 63, row = i >> 6, h = row >> 7, q = row & 127, col0 = kg * 8, hp = col0 >> 7, k0 = col0 & 127;
            u32x4 w = (u32x4){0u, 0u, 0u, 0u};
            if (h == hp) { const float* s = wsp + ((size_t)h * 128 + q) * 128 + k0; const f32x4 a = *(const f32x4*)s, b = *(const f32x4*)(s + 4);
                w.x = cvt_pk_bf16(a[0], a[1]); w.y = cvt_pk_bf16(a[2], a[3]); w.z = cvt_pk_bf16(b[0], b[1]); w.w = cvt_pk_bf16(b[2], b[3]); }
            *(u32x4*)(wbd + (size_t)row * 512 + col0) = w;
        }
    }
    {
        LAS float* EBr = (LAS float*)lds; LAS float* EBi = EBr + 1024;
        float* klag = (float*)(ws + WS_KLAG);
        for (int it = bid; it < NGRP * 63; it += G) {
            const int g = it / 63, l = it % 63;
            float accv = 0.f;
            for (int dir = 0; dir < 2; ++dir) {
                if ((dir == 0 && l > 31) || (dir == 1 && l < 31)) continue;
                const int tau = dir == 0 ? 31 - l : l - 31; const int o = dir * 7;
                const float* lre = p.in[11 + o]; const float* lim = p.in[12 + o]; const float* lst = p.in[13 + o];
                const float* bre = p.in[14 + o]; const float* bim = p.in[15 + o]; const float* cre = p.in[16 + o]; const float* cim = p.in[17 + o];
                const double dt = exp((double)lst[g]);
                __syncthreads();
                for (int idx = tid; idx < 1024; idx += 512) { const int pp = idx >> 4, hp = idx & 15; const float a = lre[g * 64 + pp], b = lim[g * 64 + pp];
                    double er, ei, fr, fi; s5_pow(a, b, dt, tau, er, ei); s5_f(a, b, dt, fr, fi);
                    const double gr = er * fr - ei * fi, gi = er * fi + ei * fr; const double br = bre[(g * 64 + pp) * 16 + hp], bi = bim[(g * 64 + pp) * 16 + hp];
                    EBr[idx] = (float)(gr * br - gi * bi); EBi[idx] = (float)(gr * bi + gi * br); }
                __syncthreads();
                if (tid < 256) { const int h = tid >> 4, hp = tid & 15; const float* cr = cre + (g * 16 + h) * 64; const float* ci = cim + (g * 16 + h) * 64; float s = 0.f;
                    for (int pp = 0; pp < 64; ++pp) s += cr[pp] * EBr[pp * 16 + hp] - ci[pp] * EBi[pp * 16 + hp];
                    accv += s; }
            }
            if (tid < 256) { const int h = tid >> 4, hp = tid & 15; if (l == 31 && h == hp) accv += p.in[25][g * 16 + h]; klag[((size_t)g * 63 + l) * 256 + tid] = accv; }
        }
        __syncthreads();
    }
    {
        bf16_t* w1s = (bf16_t*)(ws + WS_W1S); bf16_t* w2s = (bf16_t*)(ws + WS_W2S);
        for (int it = bid; it < NGRP * 2 * 32; it += G) {
            const int t = it & 31, dir = (it >> 5) & 1, g = it >> 6; const int o = dir * 7;
            const int pp = tid & 63, hh = tid >> 6;
            const float a = p.in[11 + o][g * 64 + pp], b = p.in[12 + o][g * 64 + pp]; const double dt = exp((double)p.in[13 + o][g]);
            double e1r, e1i, e2r, e2i, fr, fi;
            s5_pow(a, b, dt, dir == 0 ? 31 - t : t, e1r, e1i); s5_pow(a, b, dt, dir == 0 ? t + 1 : 32 - t, e2r, e2i); s5_f(a, b, dt, fr, fi);
            const double gr = e1r * fr - e1i * fi, gi = e1r * fi + e1i * fr;
#pragma unroll
            for (int j = 0; j < 2; ++j) { const int h = 2 * hh + j;
                const double br = p.in[14 + o][(g * 64 + pp) * 16 + h], bi = p.in[15 + o][(g * 64 + pp) * 16 + h];
                w1s[((size_t)g * 256 + dir * 128 + pp) * 512 + t * 16 + h] = f2bf((float)(gr * br - gi * bi));
                w1s[((size_t)g * 256 + dir * 128 + 64 + pp) * 512 + t * 16 + h] = f2bf((float)(gr * bi + gi * br));
                const double cr = p.in[16 + o][(g * 16 + h) * 64 + pp], ci = p.in[17 + o][(g * 16 + h) * 64 + pp];
                w2s[((size_t)g * 512 + t * 16 + h) * KS2 + 512 + dir * 128 + pp] = f2bf((float)(cr * e2r - ci * e2i));
                w2s[((size_t)g * 512 + t * 16 + h) * KS2 + 512 + dir * 128 + 64 + pp] = f2bf((float)(-(cr * e2i + ci * e2r))); }
        }
    }
}

template <bool FROM_IN>
__device__ __forceinline__ void pass_modnorm(const P& p, const float* gain, int shidx) {
    const int lane = threadIdx.x & 63, wave = threadIdx.x >> 6;
    const float* MOD = (const float*)(p.ws + WS_MOD); bf16_t* H = (bf16_t*)(p.ws + WS_H);
    for (int row = blockIdx.x * 8 + wave; row < MT; row += gridDim.x * 8) {
        const float* src = FROM_IN ? (row < MP ? p.in[0] + (size_t)row * DM : p.in[1] + (size_t)(row - MP) * DM) : p.out + (size_t)row * DM;
        f32x4 v[4]; float ss = 0.f;
#pragma unroll
        for (int i = 0; i < 4; ++i) { v[i] = *(const f32x4*)(src + i * 256 + lane * 4); ss += v[i][0] * v[i][0] + v[i][1] * v[i][1] + v[i][2] * v[i][2] + v[i][3] * v[i][3]; }
        ss = wave_sum(ss); const float rstd = rsqrtf(ss * (1.0f / DM) + EPS);
        const float* sh = MOD + (size_t)batch_of_row(row) * 9216 + shidx * 1024; const float* sc = sh + 1024;
#pragma unroll
        for (int i = 0; i < 4; ++i) { const int c = i * 256 + lane * 4; const f32x4 g4 = *(const f32x4*)(gain + c), s4 = *(const f32x4*)(sc + c), h4 = *(const f32x4*)(sh + c);
            const f32x4 o = v[i] * rstd * g4 * (s4 + 1.0f) + h4; u32x2 w; w.x = cvt_pk_bf16(o[0], o[1]); w.y = cvt_pk_bf16(o[2], o[3]); *(u32x2*)(H + (size_t)row * DM + c) = w; }
    }
}
__device__ __forceinline__ void pass_final(const P& p) {
    const int lane = threadIdx.x & 63, wave = threadIdx.x >> 6; const float* gain = p.in[37];
    for (int row = blockIdx.x * 8 + wave; row < MT; row += gridDim.x * 8) {
        float* src = p.out + (size_t)row * DM; f32x4 v[4]; float ss = 0.f;
#pragma unroll
        for (int i = 0; i < 4; ++i) { v[i] = *(const f32x4*)(src + i * 256 + lane * 4); ss += v[i][0] * v[i][0] + v[i][1] * v[i][1] + v[i][2] * v[i][2] + v[i][3] * v[i][3]; }
        ss = wave_sum(ss); const float rstd = rsqrtf(ss * (1.0f / DM) + EPS);
#pragma unroll
        for (int i = 0; i < 4; ++i) { const int c = i * 256 + lane * 4; *(f32x4*)(src + c) = v[i] * rstd * *(const f32x4*)(gain + c); }
    }
}
__device__ __forceinline__ void pass_ycat(const P& p) {
    const int lane = threadIdx.x & 63, wave = threadIdx.x >> 6;
    const bf16_t* ya = (const bf16_t*)(p.ws + WS_VG); const bf16_t* yb = (const bf16_t*)(p.ws + WS_UGM); bf16_t* H = (bf16_t*)(p.ws + WS_H);
    const float* ga = p.in[31] + lane * 8; const float* gb = p.in[32] + lane * 8;
    for (int row = blockIdx.x * 8 + wave; row < MT; row += gridDim.x * 8) {
        const u32x4 a = *(const u32x4*)(ya + (size_t)row * 512 + lane * 8), b = *(const u32x4*)(yb + (size_t)row * 512 + lane * 8);
        float av[8] = {bflo(a.x), bfhi(a.x), bflo(a.y), bfhi(a.y), bflo(a.z), bfhi(a.z), bflo(a.w), bfhi(a.w)};
        float bv[8] = {bflo(b.x), bfhi(b.x), bflo(b.y), bfhi(b.y), bflo(b.z), bfhi(b.z), bflo(b.w), bfhi(b.w)};
        float sa = 0.f, sb = 0.f;
#pragma unroll
        for (int j = 0; j < 8; ++j) { sa += av[j] * av[j]; sb += bv[j] * bv[j]; }
        sa = wave_sum(sa); sb = wave_sum(sb);
        const float ra = rsqrtf(sa * (1.0f / 512) + EPS), rb = rsqrtf(sb * (1.0f / 512) + EPS);
        const f32x4 ga0 = *(const f32x4*)ga, ga1 = *(const f32x4*)(ga + 4), gb0 = *(const f32x4*)gb, gb1 = *(const f32x4*)(gb + 4);
        u32x4 wa, wb;
        wa.x = cvt_pk_bf16(av[0] * ra * ga0[0], av[1] * ra * ga0[1]); wa.y = cvt_pk_bf16(av[2] * ra * ga0[2], av[3] * ra * ga0[3]);
        wa.z = cvt_pk_bf16(av[4] * ra * ga1[0], av[5] * ra * ga1[1]); wa.w = cvt_pk_bf16(av[6] * ra * ga1[2], av[7] * ra * ga1[3]);
        wb.x = cvt_pk_bf16(bv[0] * rb * gb0[0], bv[1] * rb * gb0[1]); wb.y = cvt_pk_bf16(bv[2] * rb * gb0[2], bv[3] * rb * gb0[3]);
        wb.z = cvt_pk_bf16(bv[4] * rb * gb1[0], bv[5] * rb * gb1[1]); wb.w = cvt_pk_bf16(bv[6] * rb * gb1[2], bv[7] * rb * gb1[3]);
        *(u32x4*)(H + (size_t)row * DM + lane * 8) = wa; *(u32x4*)(H + (size_t)row * DM + 512 + lane * 8) = wb;
    }
}
__device__ __forceinline__ void fill_kmat(const P& p) {
    const float* klag = (const float*)(p.ws + WS_KLAG); bf16_t* w2s = (bf16_t*)(p.ws + WS_W2S);
    for (int i = blockIdx.x * 512 + threadIdx.x; i < NGRP * 512 * 64; i += gridDim.x * 512) {
        const int kg = i & 63, n = (i >> 6) & 511, g = i >> 15, t = n >> 4, h = n & 15, s = kg >> 1, hp0 = (kg & 1) * 8, l = s - t + 31;
        const float* src = klag + ((size_t)g * 63 + l) * 256 + h * 16 + hp0; const f32x4 a = *(const f32x4*)src, b = *(const f32x4*)(src + 4);
        u32x4 w; w.x = cvt_pk_bf16(a[0], a[1]); w.y = cvt_pk_bf16(a[2], a[3]); w.z = cvt_pk_bf16(b[0], b[1]); w.w = cvt_pk_bf16(b[2], b[3]);
        *(u32x4*)(w2s + ((size_t)g * 512 + n) * KS2 + s * 16 + hp0) = w;
    }
}
__device__ __forceinline__ void pass_ln_transpose(const P& p, LAS unsigned char* lds) {
    const int tid = threadIdx.x, lane = tid & 63, wave = tid >> 6;
    LAS float* ST = (LAS float*)lds;
    LAS bf16_t* T = (LAS bf16_t*)(lds + 1024);
    const bf16_t* vg = (const bf16_t*)(p.ws + WS_VG); bf16_t* vt = (bf16_t*)(p.ws + WS_VT);
    const float* lg = p.in[27]; const float* lb = p.in[28];
    for (int bn = blockIdx.x; bn < MT / 128; bn += gridDim.x) {
        __syncthreads();
        for (int tt = 0; tt < 16; ++tt) { const int k = wave * 16 + tt; const u32x4 a = *(const u32x4*)(vg + ((size_t)bn * 128 + k) * 512 + lane * 8);
            const float x[8] = {bflo(a.x), bfhi(a.x), bflo(a.y), bfhi(a.y), bflo(a.z), bfhi(a.z), bflo(a.w), bfhi(a.w)};
            float s = 0.f, q = 0.f;
#pragma unroll
            for (int j = 0; j < 8; ++j) { s += x[j]; q += x[j] * x[j]; }
            s = wave_sum(s); q = wave_sum(q); const float mu = s * (1.0f / 512), var = fmaxf(q * (1.0f / 512) - mu * mu, 0.f);
            if (lane == 0) { ST[k * 2] = mu; ST[k * 2 + 1] = rsqrtf(var + EPS); } }
        __syncthreads();
        for (int h = 0; h < 4; ++h) {
#pragma unroll
            for (int i = 0; i < 4; ++i) { const int idx = tid + i * 512, k = idx >> 4, c0 = (idx & 15) * 8;
                const u32x4 a = *(const u32x4*)(vg + ((size_t)bn * 128 + k) * 512 + h * 128 + c0); const float mu = ST[k * 2], rs = ST[k * 2 + 1];
                const float x[8] = {bflo(a.x), bfhi(a.x), bflo(a.y), bfhi(a.y), bflo(a.z), bfhi(a.z), bflo(a.w), bfhi(a.w)};
                const f32x4 g0 = *(const f32x4*)(lg + h * 128 + c0), g1 = *(const f32x4*)(lg + h * 128 + c0 + 4), b0 = *(const f32x4*)(lb + h * 128 + c0), b1 = *(const f32x4*)(lb + h * 128 + c0 + 4);
#pragma unroll
                for (int j = 0; j < 4; ++j) { T[(c0 + j) * 136 + k] = f2bf((x[j] - mu) * rs * g0[j] + b0[j]); T[(c0 + 4 + j) * 136 + k] = f2bf((x[4 + j] - mu) * rs * g1[j] + b1[j]); } }
            __syncthreads();
#pragma unroll
            for (int i = 0; i < 4; ++i) { const int idx = tid + i * 512, c = idx >> 4, kg = idx & 15;
                *(u32x4*)(vt + (((size_t)bn * 128 + c) * 4 + h) * 128 + kg * 8) = *(const LAS u32x4*)(T + c * 136 + kg * 8); }
            __syncthreads();
        }
    }
}
__device__ __forceinline__ void pass_chunk_scan(const P& p) {
    const float* sloc = (const float*)(p.ws + WS_SLOC); bf16_t* ug = (bf16_t*)(p.ws + WS_UG);
    for (int T = blockIdx.x * 512 + threadIdx.x; T < 16 * NGRP * 128; T += gridDim.x * 512) {
        const int j = T & 127, dir = j >> 6, pp = j & 63, g = (T >> 7) & 31, b = T >> 12;
        const int cb = b < 8 ? b * 64 : 512 + (b - 8) * 256, nc = b < 8 ? 64 : 256; const int o = dir * 7;
        const double dt = exp((double)p.in[13 + o][g]); double er, ei; s5_pow(p.in[11 + o][g * 64 + pp], p.in[12 + o][g * 64 + pp], dt, TCH, er, ei);
        const float ar = (float)er, ai = (float)ei;
        const float* lp = sloc + ((size_t)g * NCHK + cb) * 256 + dir * 128 + pp;
        bf16_t* up = ug + ((size_t)g * NCHK + cb) * KS2 + 512 + dir * 128 + pp;
        float sr = 0.f, si = 0.f;
        for (int c0 = 0; c0 < nc; c0 += 8) {
            float lr[8], li[8];
#pragma unroll
            for (int q = 0; q < 8; ++q) { const int c = dir == 0 ? c0 + q : nc - 1 - (c0 + q); lr[q] = lp[(size_t)c * 256]; li[q] = lp[(size_t)c * 256 + 64]; }
#pragma unroll
            for (int q = 0; q < 8; ++q) { const int c = dir == 0 ? c0 + q : nc - 1 - (c0 + q);
                up[(size_t)c * KS2] = f2bf(sr); up[(size_t)c * KS2 + 64] = f2bf(si);
                const float nr = ar * sr - ai * si + lr[q], ni = ar * si + ai * sr + li[q]; sr = nr; si = ni; }
        }
    }
}

__global__ void __launch_bounds__(512, 2) mega(P p) {
    extern __shared__ __attribute__((aligned(16))) unsigned char lds_raw[];
    LAS unsigned char* lds = (LAS unsigned char*)lds_raw;
    cg::grid_group grid = cg::this_grid();
    const int lo = p.ph_lo, hi = p.ph_hi, G = gridDim.x, bid = blockIdx.x;
    unsigned char* ws = p.ws;
    const float* MOD = (const float*)(ws + WS_MOD);
    bf16_t* H = (bf16_t*)(ws + WS_H); bf16_t* HID = (bf16_t*)(ws + WS_HID);
    bf16_t* UG = (bf16_t*)(ws + WS_UG); bf16_t* UGM = (bf16_t*)(ws + WS_UGM); bf16_t* VG = (bf16_t*)(ws + WS_VG); bf16_t* VT = (bf16_t*)(ws + WS_VT);
    float* SLOC = (float*)(ws + WS_SLOC); bf16_t* Y = (bf16_t*)(ws + WS_SLOC);
#define IN(k) (lo <= (k) && (k) < hi)
#define SYNC(k) do { if (IN(k) && IN((k) + 1)) grid.sync(); } while (0)
    if (IN(0)) phase0(p, lds);
    SYNC(0);
    if (IN(1)) { pass_modnorm<true>(p, p.in[6], 0); fill_kmat(p); }
    SYNC(1);
    if (IN(2)) { pg8::Gemm g{H, (const bf16_t*)(ws + WS_WIN1), DM, DM, DM, 0, 0}; pg8::Order S; S.init(MT / 256, NIN / 256, 1, G, bid); EpiSwiglu E{HID}; pg8::gemm_phase(lds, g, S, E); }
    SYNC(2);
    if (IN(3)) { pg8::Gemm g{HID, (const bf16_t*)(ws + WS_WOUT1), DFF, DFF, DFF, 0, 0}; pg8::Order S; S.init(MT / 256, DM / 256, 1, G, bid);
        EpiResid E{p.in[0], p.in[1], p.out, MOD + 2 * 1024, 0.5f}; pg8::gemm_phase(lds, g, S, E); }
    SYNC(3);
    if (IN(4)) pass_modnorm<false>(p, p.in[9], 3);
    SYNC(4);
    if (IN(5)) { pg8::Gemm g{H, (const bf16_t*)(ws + WS_WMIXIN), DM, DM, DM, 0, 0}; pg8::Order S; S.init(MT / 256, NMIX / 256, 1, G, bid); EpiMixIn E{UG, UGM, VG}; pg8::gemm_phase(lds, g, S, E); }
    SYNC(5);
    if (IN(6)) { pass_ln_transpose(p, lds);
        pg8::Gemm g{UG, (const bf16_t*)(ws + WS_W1S), KS2, 512, 512, (size_t)NCHK * KS2, (size_t)256 * 512}; pg8::Order S; S.init(NCHK / 256, 1, NGRP, G, bid); EpiS1 E{SLOC}; pg8::gemm_phase(lds, g, S, E); }
    SYNC(6);
    if (IN(7)) { pass_chunk_scan(p);
        pg8::Gemm g{(const bf16_t*)(ws + WS_WBD), VT, 512, 512, 512, 0, 0}; pg8::Order S; S.init(2, MT / 256, 1, G, bid); EpiSpatial E{UGM, p.in[30]}; pg8::gemm_phase(lds, g, S, E); }
    SYNC(7);
    if (IN(8)) { pg8::Gemm g{UG, (const bf16_t*)(ws + WS_W2S), KS2, KS2, KS2, (size_t)NCHK * KS2, (size_t)512 * KS2}; pg8::Order S; S.init(NCHK / 256, 2, NGRP, G, bid); EpiS2 E{Y}; pg8::gemm_phase(lds, g, S, E); }
    SYNC(8);
    if (IN(9)) { pg8::Gemm g{Y, (const bf16_t*)(ws + WS_WGLU), 512, 512, 512, 0, 0}; pg8::Order S; S.init(MT / 256, 2, 1, G, bid); EpiGlu E{Y, VG}; pg8::gemm_phase(lds, g, S, E); }
    SYNC(9);
    if (IN(10)) pass_ycat(p);
    SYNC(10);
    if (IN(11)) { pg8::Gemm g{H, (const bf16_t*)(ws + WS_WMIXOUT), DM, DM, DM, 0, 0}; pg8::Order S; S.init(MT / 256, DM / 256, 1, G, bid);
        EpiResid E{p.out, p.out + (size_t)MP * DM, p.out, MOD + 5 * 1024, 1.0f}; pg8::gemm_phase(lds, g, S, E); }
    SYNC(11);
    if (IN(12)) pass_modnorm<false>(p, p.in[34], 6);
    SYNC(12);
    if (IN(13)) { pg8::Gemm g{H, (const bf16_t*)(ws + WS_WIN2), DM, DM, DM, 0, 0}; pg8::Order S; S.init(MT / 256, NIN / 256, 1, G, bid); EpiSwiglu E{HID}; pg8::gemm_phase(lds, g, S, E); }
    SYNC(13);
    if (IN(14)) { pg8::Gemm g{HID, (const bf16_t*)(ws + WS_WOUT2), DFF, DFF, DFF, 0, 0}; pg8::Order S; S.init(MT / 256, DM / 256, 1, G, bid);
        EpiResid E{p.out, p.out + (size_t)MP * DM, p.out, MOD + 8 * 1024, 0.5f}; pg8::gemm_phase(lds, g, S, E); }
    SYNC(14);
    if (IN(15)) pass_final(p);
#undef IN
#undef SYNC
}

extern "C" void kernel_launch(void* const* d_in, const int* in_sizes, int n_in, void* d_out, int out_size, void* d_ws, size_t ws_size, hipStream_t stream) {
    static int grid = 0;
    if (grid == 0) {
        if (n_in != 38 || out_size != MT * DM || ws_size < WS_END) { fprintf(stderr, "kernel_launch: unexpected shapes: n_in %d out %d ws %zu (need %zu)\n", n_in, out_size, ws_size, (size_t)WS_END); grid = -1; return; }
        int dev = 0, cus = 0, per_cu = 0;
        hipGetDevice(&dev); hipDeviceGetAttribute(&cus, hipDeviceAttributeMultiprocessorCount, dev);
        if (hipFuncSetAttribute((const void*)mega, hipFuncAttributeMaxDynamicSharedMemorySize, LDS_BYTES) != hipSuccess) { fprintf(stderr, "kernel_launch: hipFuncSetAttribute failed\n"); grid = -1; return; }
        hipOccupancyMaxActiveBlocksPerMultiprocessor(&per_cu, (const void*)mega, 512, LDS_BYTES);
        if (per_cu < 1) per_cu = 1;
        grid = cus * 1;
        (void)hipGetLastError();
        fprintf(stderr, "kernel_launch: cus %d per_cu %d grid %d ws need %zu have %zu\n", cus, per_cu, grid, (size_t)WS_END, ws_size);
    }
    if (grid < 0) return;
    hipMemsetAsync((char*)d_ws + WS_MOD, 0, MOD_BYTES, stream);
    P p{};
    for (int i = 0; i < 38; ++i) p.in[i] = (const float*)d_in[i];
    p.out = (float*)d_out; p.ws = (unsigned char*)d_ws;
#if N_LAUNCH_MODE == 0
    p.ph_lo = 0; p.ph_hi = NPHASE;
    void* args[] = {&p};
    hipError_t e = hipLaunchCooperativeKernel((const void*)mega, dim3(grid), dim3(512), args, LDS_BYTES, stream);
    if (e != hipSuccess) fprintf(stderr, "cooperative launch failed: %s (grid %d)\n", hipGetErrorString(e), grid);
#else
    for (int k = 0; k < NPHASE; ++k) { p.ph_lo = k; p.ph_hi = k + 1; hipLaunchKernelGGL(mega, dim3(grid), dim3(512), LDS_BYTES, stream, p); }
#endif
}
```

```cpp
#include <hip/hip_runtime.h>
#include <hip/hip_cooperative_groups.h>
#include <cstdio>
namespace cg = cooperative_groups;

#define LAS __attribute__((address_space(3)))
typedef unsigned short bf16_t;
typedef short bf16x8 __attribute__((ext_vector_type(8)));
typedef float f32x4 __attribute__((ext_vector_type(4)));
typedef unsigned u32x4 __attribute__((ext_vector_type(4)));
typedef unsigned u32x2 __attribute__((ext_vector_type(2)));

#ifndef N_LAUNCH_MODE
#define N_LAUNCH_MODE 0
#endif

constexpr int MT = 81920;
constexpr int MP = 16384;
constexpr int DM = 1024, DFF = 2816, NIN = 5632, NMIX = 1536;
constexpr int NGRP = 32, TCH = 32, NCHK = MT / TCH  , KS2 = 768;
constexpr float EPS = 1e-6f;
constexpr int NPHASE = 13;

constexpr size_t al256(size_t x) { return (x + 255) & ~(size_t)255; }
constexpr size_t WS_MOD = 0;
constexpr size_t MOD_BYTES = 16 * 9216 * 4;
constexpr size_t WS_RSS1 = WS_MOD + MOD_BYTES;
constexpr size_t WS_RSS2 = WS_RSS1 + (size_t)MT * 4;
constexpr size_t WS_RSSA = WS_RSS2 + (size_t)MT * 4;
constexpr size_t WS_RSSB = WS_RSSA + (size_t)MT * 4;
constexpr size_t ZERO_BYTES = WS_RSSB + (size_t)MT * 4;
constexpr size_t WS_SHW2 = ZERO_BYTES;
constexpr size_t WS_SHW3 = WS_SHW2 + 16 * 1536 * 4;
constexpr size_t WS_WIN1 = al256(WS_SHW3 + 16 * 5632 * 4);
constexpr size_t WS_WIN2 = WS_WIN1 + (size_t)NIN * DM * 2;
constexpr size_t WS_WOUT1 = WS_WIN2 + (size_t)NIN * DM * 2;
constexpr size_t WS_WOUT2 = WS_WOUT1 + (size_t)DM * DFF * 2;
constexpr size_t WS_WMIXIN = WS_WOUT2 + (size_t)DM * DFF * 2;
constexpr size_t WS_WGLU = WS_WMIXIN + (size_t)NMIX * DM * 2;
constexpr size_t WS_WMIXOUT = WS_WGLU + 512 * 512 * 2;
constexpr size_t WS_WBD = WS_WMIXOUT + (size_t)DM * DM * 2;
constexpr size_t WS_KLAG = WS_WBD + 512 * 512 * 2;
constexpr size_t WS_W1S = WS_KLAG + (size_t)NGRP * 63 * 256 * 4;
constexpr size_t WS_W2S = WS_W1S + (size_t)NGRP * 256 * 512 * 2;
constexpr size_t WS_H = WS_W2S + (size_t)NGRP * 512 * KS2 * 2;
constexpr size_t WS_H2 = WS_H + (size_t)MT * DM * 2;
constexpr size_t WS_R = WS_H2 + (size_t)MT * DM * 2;
constexpr size_t WS_HID = WS_R;
constexpr size_t WS_UG = WS_R;
constexpr size_t WS_UGM = WS_UG + (size_t)NGRP * NCHK * KS2 * 2;
constexpr size_t WS_VG = WS_UGM + (size_t)MT * 512 * 2;
constexpr size_t WS_VT = WS_VG + (size_t)MT * 512 * 2;
constexpr size_t WS_SLOC = WS_VT + (size_t)MT * 512 * 2;
constexpr size_t WS_END = WS_R + (size_t)MT * DFF * 2;
static_assert(WS_SLOC + (size_t)NGRP * NCHK * 256 * 4 <= WS_END, "mixer buffers must fit the HID region");

constexpr int LDS_BYTES = 131072;

struct P { const float* in[38]; float* out; unsigned char* ws; int ph_lo, ph_hi; };

__device__ __forceinline__ unsigned cvt_pk_bf16(float lo, float hi) { unsigned r; asm volatile("v_cvt_pk_bf16_f32 %0, %1, %2" : "=v"(r) : "v"(lo), "v"(hi)); return r; }
__device__ __forceinline__ bf16_t f2bf(float f) { return (bf16_t)(cvt_pk_bf16(f, 0.f) & 0xffffu); }
__device__ __forceinline__ float bflo(unsigned w) { return __uint_as_float(w << 16); }
__device__ __forceinline__ float bfhi(unsigned w) { return __uint_as_float(w & 0xffff0000u); }
__device__ __forceinline__ float wave_sum(float v) {
#pragma unroll
    for (int o = 32; o; o >>= 1) v += __shfl_xor(v, o);
    return v;
}
__device__ __forceinline__ float sigmoid_f(float a) { return __builtin_amdgcn_rcpf(1.f + __expf(-a)); }
__device__ __forceinline__ float gelu_f(float x) { return x * sigmoid_f(1.5957691216f * (x + 0.044715f * x * x * x)); }
__device__ __forceinline__ float silu_f(float x) { return x * sigmoid_f(x); }
__device__ __forceinline__ int batch_of_row(int row) { return row < MP ? (row >> 11) : 8 + ((row - MP) >> 13); }
__device__ __forceinline__ int batch_of_tile(int pm) { return pm < 64 ? (pm >> 3) : 8 + ((pm - 64) >> 5); }

namespace pg8 {
constexpr int BM = 256, BK = 64, HALF = 128, HTB = HALF * BK * 2, NXCD = 8, WGM = 8;
__device__ __forceinline__ int lds_byte(int r, int c) { const int st = (r >> 4) * 2 + (c >> 5), rr = r & 15, cc = c & 31, ob = rr * 64 + cc * 2; return st * 1024 + (ob ^ (((ob >> 9) & 1) << 5)); }
__device__ __forceinline__ void stage_rc(int b, int& R, int& C) { const int st = b / 1024, sb = b % 1024, swz = sb ^ (((sb >> 9) & 1) << 5); R = (st >> 1) * 16 + swz / 64; C = (st & 1) * 32 + (swz % 64) / 2; }
__device__ __forceinline__ int perm32(int rho) { const int n = rho >> 4, i = rho & 15; return 8 * (i >> 2) + 4 * n + (i & 3); }

struct Unit { int pm, pn, g; };
struct Gemm { const bf16_t* A; const bf16_t* Bt; int lda, ldb, K; size_t gsA, gsB; };
struct Order {
    int nM, nN, ntot, G, c;
    __device__ void init(int nM_, int nN_, int nG_, int G_, int c_) { nM = nM_; nN = nN_; ntot = nM_ * nN_ * nG_; G = G_; c = c_; }
    __device__ bool next(int i, Unit& u) const {
        const long L = (long)i * G + c; if (L >= ntot) return false;
        int wgid = (int)L; { const int q = ntot / NXCD, r = ntot % NXCD, xcd = wgid % NXCD, off = wgid / NXCD; wgid = (xcd < r ? xcd * (q + 1) : r * (q + 1) + (xcd - r) * q) + off; }
        const int per = nM * nN; u.g = wgid / per; const int w = wgid - u.g * per;
        const int nig = WGM * nN, gid = w / nig, fm = gid * WGM, gsz = (nM - fm) < WGM ? (nM - fm) : WGM;
        u.pm = fm + ((w % nig) % gsz); u.pn = (w % nig) / gsz; return true;
    }
};

template <class Epi>
__device__ __forceinline__ void gemm_phase(LAS unsigned char* lds, const Gemm g, const Order& S, const Epi& E) {
    const int tid = threadIdx.x, wid = __builtin_amdgcn_readfirstlane(tid >> 6), lane = tid & 63, wr = wid >> 2, wc = wid & 3, fr = lane & 15, fq = lane >> 4;
    const int K = g.K, nt = K / BK;
    unsigned voffA[2], voffB[2];
#pragma unroll
    for (int i = 0; i < 2; ++i) { int R, C; stage_rc(tid * 16 + i * 8192, R, C); const int Rb = Epi::PERM ? ((R & ~31) + perm32(R & 31)) : R;
        voffA[i] = (unsigned)(R * g.lda + C) * 2u; voffB[i] = (unsigned)(Rb * g.ldb + C) * 2u; }
    const size_t kstep = (size_t)(BK * 2);
    const size_t hstepA = (size_t)HALF * g.lda * 2, hstepB = (size_t)HALF * g.ldb * 2;
    const size_t tstepA = 2 * hstepA, tstepB = 2 * hstepB;
    const unsigned ldsw = (unsigned)wid * 1024u;
    const int aoff = lds_byte(wr * 64 + fr, fq * 8), boff = lds_byte(wc * 32 + fr, fq * 8);
#define PG8_SA(b, h) (((b) * 2 + (h)) * HTB)
#define PG8_SB(b, h) ((4 + (b) * 2 + (h)) * HTB)
#define PG8_STAGE(bufoff, gbase, voff) do { _Pragma("unroll") for (int _i = 0; _i < 2; ++_i) \
        __builtin_amdgcn_global_load_lds((const unsigned*)((const char*)(gbase) + (voff)[_i]), (LAS unsigned*)(lds + (bufoff) + ldsw + _i * 8192), 16, 0, 0); } while (0)
#define PG8_LDA(dst, b, h) do { _Pragma("unroll") for (int m = 0; m < 4; ++m) _Pragma("unroll") for (int k = 0; k < 2; ++k) dst[m][k] = *(const LAS bf16x8*)(lds + PG8_SA(b, h) + aoff + m * 2048 + k * 1024); } while (0)
#define PG8_LDB(dst, b, h) do { _Pragma("unroll") for (int n = 0; n < 2; ++n) _Pragma("unroll") for (int k = 0; k < 2; ++k) dst[n][k] = *(const LAS bf16x8*)(lds + PG8_SB(b, h) + boff + n * 2048 + k * 1024); } while (0)
#define PG8_MMA(ai, bj, At, Bt) do { __builtin_amdgcn_s_setprio(1); _Pragma("unroll") for (int m = 0; m < 4; ++m) _Pragma("unroll") for (int n = 0; n < 2; ++n) _Pragma("unroll") for (int k = 0; k < 2; ++k) \
        acc[ai][bj][m][n] = __builtin_amdgcn_mfma_f32_16x16x32_bf16(Bt[n][k], At[m][k], acc[ai][bj][m][n], 0, 0, 0); __builtin_amdgcn_s_setprio(0); } while (0)
#define PG8_WAIT_V(n) asm volatile("s_waitcnt vmcnt(" #n ")" ::: "memory")
#define PG8_WAIT_L(n) asm volatile("s_waitcnt lgkmcnt(" #n ")" ::: "memory")
#define PG8_BAR __builtin_amdgcn_s_barrier()
#define PG8_SCHED __builtin_amdgcn_sched_barrier(0)
#define PG8_BASEA(u) ((const char*)g.A + ((size_t)(u).g * g.gsA) * 2 + (size_t)(u).pm * tstepA)
#define PG8_BASEB(u) ((const char*)g.Bt + ((size_t)(u).g * g.gsB) * 2 + (size_t)(u).pn * tstepB)
    Unit cur, nxt; int ui = 0;
    if (!S.next(0, cur)) return;
    f32x4 acc[2][2][4][2];
#pragma unroll
    for (int a = 0; a < 2; ++a)
#pragma unroll
        for (int b = 0; b < 2; ++b)
#pragma unroll
            for (int m = 0; m < 4; ++m)
#pragma unroll
                for (int n = 0; n < 2; ++n) acc[a][b][m][n] = (f32x4){0.f, 0.f, 0.f, 0.f};
    bf16x8 At[4][2], B0[2][2], B1[2][2];
    const char* cA = PG8_BASEA(cur); const char* cB = PG8_BASEB(cur);
    PG8_STAGE(PG8_SB(0, 0), cB, voffB); PG8_STAGE(PG8_SA(0, 0), cA, voffA); PG8_STAGE(PG8_SB(0, 1), cB + hstepB, voffB); PG8_STAGE(PG8_SA(0, 1), cA + hstepA, voffA);
    if (wr == 1) PG8_BAR;
    PG8_WAIT_V(4); PG8_BAR;
    PG8_STAGE(PG8_SB(1, 0), cB + kstep, voffB); PG8_STAGE(PG8_SA(1, 0), cA + kstep, voffA); PG8_STAGE(PG8_SB(1, 1), cB + hstepB + kstep, voffB);
    PG8_WAIT_V(6); PG8_BAR;
    for (;;) {
        const bool has_next = S.next(ui + 1, nxt);
        const char* nA = has_next ? PG8_BASEA(nxt) : cA; const char* nB = has_next ? PG8_BASEB(nxt) : cB;
        for (int t = 0; t < nt; t += 2) {
            const bool last = (t == nt - 2);
            const char* a1 = cA + (size_t)(t + 1) * kstep;
            const char* a2 = last ? nA : cA + (size_t)(t + 2) * kstep; const char* b2 = last ? nB : cB + (size_t)(t + 2) * kstep;
            const char* a3 = a2 + kstep; const char* b3 = b2 + kstep;
            if constexpr (Epi::MIDSCALE) { if (t == 8) E.midscale(acc, cur, wr, fr); }
            PG8_LDB(B0, 0, 0); PG8_SCHED; PG8_LDA(At, 0, 0); PG8_STAGE(PG8_SA(1, 1), a1 + hstepA, voffA);
            PG8_WAIT_L(8); PG8_BAR; PG8_WAIT_L(0); PG8_MMA(0, 0, At, B0); PG8_BAR; PG8_SCHED;
            PG8_LDB(B1, 0, 1); PG8_STAGE(PG8_SB(0, 0), b2, voffB);
            PG8_BAR; PG8_WAIT_L(0); PG8_MMA(0, 1, At, B1); PG8_BAR;
            PG8_LDA(At, 0, 1); PG8_STAGE(PG8_SA(0, 0), a2, voffA);
            PG8_BAR; PG8_WAIT_L(0); PG8_MMA(1, 0, At, B0); PG8_BAR; PG8_SCHED;
            PG8_STAGE(PG8_SB(0, 1), b2 + hstepB, voffB);
            PG8_WAIT_V(6); PG8_BAR; PG8_MMA(1, 1, At, B1); PG8_BAR;
            PG8_LDB(B0, 1, 0); PG8_SCHED; PG8_LDA(At, 1, 0); PG8_STAGE(PG8_SA(0, 1), a2 + hstepA, voffA);
            PG8_WAIT_L(8); PG8_BAR; PG8_WAIT_L(0); PG8_MMA(0, 0, At, B0); PG8_BAR; PG8_SCHED;
            PG8_LDB(B1, 1, 1); PG8_STAGE(PG8_SB(1, 0), b3, voffB);
            PG8_BAR; PG8_WAIT_L(0); PG8_MMA(0, 1, At, B1); PG8_BAR;
            PG8_LDA(At, 1, 1); PG8_STAGE(PG8_SA(1, 0), a3, voffA);
            PG8_BAR; PG8_WAIT_L(0); PG8_MMA(1, 0, At, B0); PG8_BAR; PG8_SCHED;
            PG8_STAGE(PG8_SB(1, 1), b3 + hstepB, voffB);
            PG8_WAIT_V(6); PG8_BAR; PG8_MMA(1, 1, At, B1); PG8_BAR;
        }
        E(acc, cur, wr, wc, fr, fq);
        if (!has_next) break;
#pragma unroll
        for (int a = 0; a < 2; ++a)
#pragma unroll
            for (int b = 0; b < 2; ++b)
#pragma unroll
                for (int m = 0; m < 4; ++m)
#pragma unroll
                    for (int n = 0; n < 2; ++n) acc[a][b][m][n] = (f32x4){0.f, 0.f, 0.f, 0.f};
        cur = nxt; cA = nA; cB = nB; ++ui;
    }
    PG8_WAIT_V(0);
    if (wr == 0) PG8_BAR;
    PG8_BAR;
#undef PG8_SA
#undef PG8_SB
#undef PG8_STAGE
#undef PG8_LDA
#undef PG8_LDB
#undef PG8_MMA
#undef PG8_WAIT_V
#undef PG8_WAIT_L
#undef PG8_BAR
#undef PG8_SCHED
#undef PG8_BASEA
#undef PG8_BASEB
}
}
using pg8::Unit;
typedef const f32x4 (&AccRef)[2][2][4][2];

template <bool NORM>
struct EpiSwiglu {
    static constexpr bool PERM = true, MIDSCALE = false;
    bf16_t* hid; const float* rss; const float* shw;
    __device__ __forceinline__ void operator()(AccRef acc, const Unit& u, int wr, int wc, int fr, int fq) const {
        const int row0 = u.pm * 256 + wr * 64 + fr, col0 = u.pn * 128 + wc * 32 + 8 * fq;
        f32x4 sg0, sg1, su0, su1;
        if (NORM) { const float* sp = shw + (size_t)batch_of_tile(u.pm) * NIN + u.pn * 256 + wc * 32 + 8 * fq; sg0 = *(const f32x4*)sp; sg1 = *(const f32x4*)(sp + 4); su0 = *(const f32x4*)(sp + 128); su1 = *(const f32x4*)(sp + 132); }
#pragma unroll
        for (int ai = 0; ai < 2; ++ai)
#pragma unroll
            for (int m = 0; m < 4; ++m) {
                const int row = row0 + ai * 128 + m * 16;
                f32x4 g0 = acc[ai][0][m][0], g1 = acc[ai][0][m][1], u0 = acc[ai][1][m][0], u1 = acc[ai][1][m][1];
                if (NORM) { const float rs = rsqrtf(rss[row] * (1.0f / DM) + EPS); g0 = g0 * rs + sg0; g1 = g1 * rs + sg1; u0 = u0 * rs + su0; u1 = u1 * rs + su1; }
                u32x4 w;
                w.x = cvt_pk_bf16(silu_f(g0[0]) * u0[0], silu_f(g0[1]) * u0[1]); w.y = cvt_pk_bf16(silu_f(g0[2]) * u0[2], silu_f(g0[3]) * u0[3]);
                w.z = cvt_pk_bf16(silu_f(g1[0]) * u1[0], silu_f(g1[1]) * u1[1]); w.w = cvt_pk_bf16(silu_f(g1[2]) * u1[2], silu_f(g1[3]) * u1[3]);
                *(u32x4*)(hid + (size_t)row * DFF + col0) = w;
            }
    }
};
template <bool NORM, bool MID, bool HALFG>
struct EpiResid {
    static constexpr bool PERM = false, MIDSCALE = MID;
    static constexpr float scale = HALFG ? 0.5f : 1.0f;
    const float* srcP; const float* srcS; float* dst; const float* gate;
    bf16_t* hn; const float* gain; const float* sc; float* rss;
    const float* rsa; const float* rsb;
    __device__ __forceinline__ void midscale(f32x4 (&acc)[2][2][4][2], const Unit& u, int wr, int fr) const {
        const size_t row0 = (size_t)(u.pm * 256 + wr * 64 + fr);
        const float* pa = rsa + row0; const float* pb = rsb + row0;
#pragma unroll
        for (int ai = 0; ai < 2; ++ai)
#pragma unroll
            for (int m = 0; m < 4; ++m) {
                const float sa = __hip_atomic_load(pa + (ai * 128 + m * 16), __ATOMIC_RELAXED, __HIP_MEMORY_SCOPE_AGENT), sb = __hip_atomic_load(pb + (ai * 128 + m * 16), __ATOMIC_RELAXED, __HIP_MEMORY_SCOPE_AGENT);
                const float ra = rsqrtf(sa * (1.0f / 512) + EPS), rb = rsqrtf(sb * (1.0f / 512) + EPS), q = ra * __builtin_amdgcn_rcpf(rb);
#pragma unroll
                for (int bj = 0; bj < 2; ++bj)
#pragma unroll
                    for (int n = 0; n < 2; ++n) acc[ai][bj][m][n] *= q;
            }
    }
    __device__ __forceinline__ void operator()(AccRef acc, const Unit& u, int wr, int wc, int fr, int fq) const {
        const int row0 = u.pm * 256 + wr * 64 + fr, col0 = u.pn * 256 + wc * 32 + 4 * fq;
        const int b = batch_of_tile(u.pm);
        const float* src = (u.pm < 64 ? srcP : srcS - (size_t)MP * DM) + (size_t)row0 * DM + col0;
        float* dp = dst + (size_t)row0 * DM + col0;
        f32x4 gv[2][2], gs[2][2];
#pragma unroll
        for (int bj = 0; bj < 2; ++bj)
#pragma unroll
            for (int n = 0; n < 2; ++n) { const int c = col0 + bj * 128 + n * 16; gv[bj][n] = *(const f32x4*)(gate + (size_t)b * 9216 + c) * scale;
                if (NORM) gs[bj][n] = *(const f32x4*)(gain + c) * (*(const f32x4*)(sc + (size_t)b * 9216 + c) + 1.0f); }
        constexpr int MB = NORM ? 2 : 4;
#pragma unroll
        for (int ai = 0; ai < 2; ++ai)
#pragma unroll
            for (int m0 = 0; m0 < 4; m0 += MB) {
                f32x4 bs[MB][2][2];
#pragma unroll
                for (int mm = 0; mm < MB; ++mm)
#pragma unroll
                    for (int bj = 0; bj < 2; ++bj)
#pragma unroll
                        for (int n = 0; n < 2; ++n) bs[mm][bj][n] = *(const f32x4*)(src + (size_t)(ai * 128 + (m0 + mm) * 16) * DM + bj * 128 + n * 16);
#pragma unroll
                for (int mm = 0; mm < MB; ++mm) {
                    const int m = m0 + mm;
                    float rb = 1.0f; if (MID) rb = rsqrtf(rsb[row0 + ai * 128 + m * 16] * (1.0f / 512) + EPS);
                    float ss = 0.f;
#pragma unroll
                    for (int bj = 0; bj < 2; ++bj)
#pragma unroll
                        for (int n = 0; n < 2; ++n) {
                            f32x4 a = acc[ai][bj][m][n]; if (MID) a *= rb;
                            const f32x4 o = bs[mm][bj][n] + gv[bj][n] * a;
                            *(f32x4*)(dp + (size_t)(ai * 128 + m * 16) * DM + bj * 128 + n * 16) = o;
                            if (NORM) { ss += o[0] * o[0] + o[1] * o[1] + o[2] * o[2] + o[3] * o[3]; const f32x4 h = o * gs[bj][n]; u32x2 w; w.x = cvt_pk_bf16(h[0], h[1]); w.y = cvt_pk_bf16(h[2], h[3]);
                                *(u32x2*)(hn + (size_t)(row0 + ai * 128 + m * 16) * DM + col0 + bj * 128 + n * 16) = w; }
                        }
                    if (NORM) { ss += __shfl_xor(ss, 16); ss += __shfl_xor(ss, 32); if (fq == 0) unsafeAtomicAdd(rss + row0 + ai * 128 + m * 16, ss); }
                }
                asm volatile("" ::: "memory");
            }
    }
};
struct EpiMixIn {
    static constexpr bool PERM = true, MIDSCALE = false;
    bf16_t* ug; bf16_t* ugm; bf16_t* vg; const float* rss; const float* shw;
    __device__ __forceinline__ void operator()(AccRef acc, const Unit& u, int wr, int wc, int fr, int fq) const {
        const int row0 = u.pm * 256 + wr * 64 + fr, colt = wc * 32 + 8 * fq;
        const float* sp = shw + (size_t)batch_of_tile(u.pm) * NMIX + u.pn * 256 + colt;
        f32x4 sv[2][2];
#pragma unroll
        for (int bj = 0; bj < 2; ++bj)
#pragma unroll
            for (int n = 0; n < 2; ++n) sv[bj][n] = *(const f32x4*)(sp + bj * 128 + 4 * n);
        if (u.pn < 2) {
#pragma unroll
            for (int ai = 0; ai < 2; ++ai)
#pragma unroll
                for (int m = 0; m < 4; ++m) { const int row = row0 + ai * 128 + m * 16; const float rs = rsqrtf(rss[row] * (1.0f / DM) + EPS);
#pragma unroll
                    for (int bj = 0; bj < 2; ++bj) { const int c = u.pn * 256 + bj * 128 + colt; const f32x4 v0 = acc[ai][bj][m][0] * rs + sv[bj][0], v1 = acc[ai][bj][m][1] * rs + sv[bj][1];
                        u32x4 w; w.x = cvt_pk_bf16(v0[0], v0[1]); w.y = cvt_pk_bf16(v0[2], v0[3]); w.z = cvt_pk_bf16(v1[0], v1[1]); w.w = cvt_pk_bf16(v1[2], v1[3]);
                        *(u32x4*)(ug + ((size_t)(c >> 4) * NCHK + (row >> 5)) * KS2 + (row & 31) * 16 + (c & 15)) = w; } }
        } else {
            bf16_t* o = (u.pn < 4 ? ugm : vg) + (u.pn & 1) * 256 + colt;
#pragma unroll
            for (int ai = 0; ai < 2; ++ai)
#pragma unroll
                for (int m = 0; m < 4; ++m) { const int row = row0 + ai * 128 + m * 16; const float rs = rsqrtf(rss[row] * (1.0f / DM) + EPS);
#pragma unroll
                    for (int bj = 0; bj < 2; ++bj) { const f32x4 v0 = acc[ai][bj][m][0] * rs + sv[bj][0], v1 = acc[ai][bj][m][1] * rs + sv[bj][1];
                        u32x4 w; w.x = cvt_pk_bf16(gelu_f(v0[0]), gelu_f(v0[1])); w.y = cvt_pk_bf16(gelu_f(v0[2]), gelu_f(v0[3])); w.z = cvt_pk_bf16(gelu_f(v1[0]), gelu_f(v1[1])); w.w = cvt_pk_bf16(gelu_f(v1[2]), gelu_f(v1[3]));
                        *(u32x4*)(o + (size_t)row * 512 + bj * 128) = w; } }
        }
    }
};
struct EpiS1 {
    static constexpr bool PERM = false, MIDSCALE = false;
    float* sloc;
    __device__ __forceinline__ void operator()(AccRef acc, const Unit& u, int wr, int wc, int fr, int fq) const {
        const int row0 = u.pm * 256 + wr * 64 + fr, col0 = wc * 32 + 4 * fq;
#pragma unroll
        for (int ai = 0; ai < 2; ++ai)
#pragma unroll
            for (int m = 0; m < 4; ++m) { float* rp = sloc + ((size_t)u.g * NCHK + row0 + ai * 128 + m * 16) * 256 + col0;
#pragma unroll
                for (int bj = 0; bj < 2; ++bj)
#pragma unroll
                    for (int n = 0; n < 2; ++n) *(f32x4*)(rp + bj * 128 + n * 16) = acc[ai][bj][m][n]; }
    }
};
struct EpiS2 {
    static constexpr bool PERM = true, MIDSCALE = false;
    bf16_t* y;
    __device__ __forceinline__ void operator()(AccRef acc, const Unit& u, int wr, int wc, int fr, int fq) const {
        const int row0 = u.pm * 256 + wr * 64 + fr, colt = u.pn * 256 + wc * 32 + 8 * fq;
#pragma unroll
        for (int ai = 0; ai < 2; ++ai)
#pragma unroll
            for (int m = 0; m < 4; ++m) { const int chunk = row0 + ai * 128 + m * 16;
#pragma unroll
                for (int bj = 0; bj < 2; ++bj) { const int c = colt + bj * 128; const f32x4 v0 = acc[ai][bj][m][0], v1 = acc[ai][bj][m][1];
                    u32x4 w; w.x = cvt_pk_bf16(gelu_f(v0[0]), gelu_f(v0[1])); w.y = cvt_pk_bf16(gelu_f(v0[2]), gelu_f(v0[3])); w.z = cvt_pk_bf16(gelu_f(v1[0]), gelu_f(v1[1])); w.w = cvt_pk_bf16(gelu_f(v1[2]), gelu_f(v1[3]));
                    *(u32x4*)(y + ((size_t)chunk * 32 + (c >> 4)) * 512 + u.g * 16 + (c & 15)) = w; } }
    }
};
struct EpiGlu {
    static constexpr bool PERM = true, MIDSCALE = false;
    const bf16_t* y; bf16_t* h; const float* gain; float* rssa;
    __device__ __forceinline__ void operator()(AccRef acc, const Unit& u, int wr, int wc, int fr, int fq) const {
        const int row0 = u.pm * 256 + wr * 64 + fr, col0 = u.pn * 256 + wc * 32 + 8 * fq;
        f32x4 gn[2][2];
#pragma unroll
        for (int bj = 0; bj < 2; ++bj)
#pragma unroll
            for (int n = 0; n < 2; ++n) gn[bj][n] = *(const f32x4*)(gain + col0 + bj * 128 + 4 * n);
        const bf16_t* yp = y + (size_t)row0 * 512 + col0;
        u32x4 yv[2][4][2];
#pragma unroll
        for (int ai = 0; ai < 2; ++ai)
#pragma unroll
            for (int m = 0; m < 4; ++m)
#pragma unroll
                for (int bj = 0; bj < 2; ++bj) yv[ai][m][bj] = *(const u32x4*)(yp + (size_t)(ai * 128 + m * 16) * 512 + bj * 128);
#pragma unroll
        for (int ai = 0; ai < 2; ++ai)
#pragma unroll
            for (int m = 0; m < 4; ++m) { const int row = row0 + ai * 128 + m * 16; float ss = 0.f;
#pragma unroll
                for (int bj = 0; bj < 2; ++bj) { const u32x4 q = yv[ai][m][bj]; const f32x4 v0 = acc[ai][bj][m][0], v1 = acc[ai][bj][m][1];
                    f32x4 a, b; a[0] = bflo(q.x) * sigmoid_f(v0[0]); a[1] = bfhi(q.x) * sigmoid_f(v0[1]); a[2] = bflo(q.y) * sigmoid_f(v0[2]); a[3] = bfhi(q.y) * sigmoid_f(v0[3]);
                    b[0] = bflo(q.z) * sigmoid_f(v1[0]); b[1] = bfhi(q.z) * sigmoid_f(v1[1]); b[2] = bflo(q.w) * sigmoid_f(v1[2]); b[3] = bfhi(q.w) * sigmoid_f(v1[3]);
                    ss += a[0] * a[0] + a[1] * a[1] + a[2] * a[2] + a[3] * a[3] + b[0] * b[0] + b[1] * b[1] + b[2] * b[2] + b[3] * b[3];
                    a *= gn[bj][0]; b *= gn[bj][1];
                    u32x4 w; w.x = cvt_pk_bf16(a[0], a[1]); w.y = cvt_pk_bf16(a[2], a[3]); w.z = cvt_pk_bf16(b[0], b[1]); w.w = cvt_pk_bf16(b[2], b[3]);
                    *(u32x4*)(h + (size_t)row * DM + col0 + bj * 128) = w; }
                ss += __shfl_xor(ss, 16); ss += __shfl_xor(ss, 32); if (fq == 0) unsafeAtomicAdd(rssa + row, ss); }
    }
};
struct EpiSpatial {
    static constexpr bool PERM = true, MIDSCALE = false;
    const bf16_t* ugm; const float* bsp; bf16_t* h; const float* gain; float* rssb;
    __device__ __forceinline__ void operator()(AccRef acc, const Unit& u, int wr, int wc, int fr, int fq) const {
        const int row0 = u.pm * 256 + wr * 64 + fr, col0 = u.pn * 256 + wc * 32 + 8 * fq, cc = wc * 32 + 8 * fq;
        const int q0 = row0 & 127;
        const bf16_t* up = ugm + ((size_t)(u.pn * 2) * 128 + q0) * 512 + cc;
        u32x4 uv[2][4][2];
#pragma unroll
        for (int ai = 0; ai < 2; ++ai)
#pragma unroll
            for (int m = 0; m < 4; ++m)
#pragma unroll
                for (int bj = 0; bj < 2; ++bj) uv[ai][m][bj] = *(const u32x4*)(up + (size_t)(bj * 128 + m * 16) * 512 + (u.pm * 2 + ai) * 128);
#pragma unroll
        for (int ai = 0; ai < 2; ++ai) {
            const int hh = u.pm * 2 + ai;
            const f32x4 g0 = *(const f32x4*)(gain + hh * 128 + cc), g1 = *(const f32x4*)(gain + hh * 128 + cc + 4);
#pragma unroll
            for (int m = 0; m < 4; ++m) { const int q = q0 + m * 16; const float bq = bsp[hh * 128 + q];
#pragma unroll
                for (int bj = 0; bj < 2; ++bj) { const size_t tok = (size_t)(u.pn * 2 + bj) * 128 + q;
                    const u32x4 w0 = uv[ai][m][bj]; const f32x4 v0 = acc[ai][bj][m][0], v1 = acc[ai][bj][m][1];
                    f32x4 a, b; a[0] = bflo(w0.x) * (v0[0] + bq); a[1] = bfhi(w0.x) * (v0[1] + bq); a[2] = bflo(w0.y) * (v0[2] + bq); a[3] = bfhi(w0.y) * (v0[3] + bq);
                    b[0] = bflo(w0.z) * (v1[0] + bq); b[1] = bfhi(w0.z) * (v1[1] + bq); b[2] = bflo(w0.w) * (v1[2] + bq); b[3] = bfhi(w0.w) * (v1[3] + bq);
                    float ss = a[0] * a[0] + a[1] * a[1] + a[2] * a[2] + a[3] * a[3] + b[0] * b[0] + b[1] * b[1] + b[2] * b[2] + b[3] * b[3];
                    a *= g0; b *= g1;
                    u32x4 w; w.x = cvt_pk_bf16(a[0], a[1]); w.y = cvt_pk_bf16(a[2], a[3]); w.z = cvt_pk_bf16(b[0], b[1]); w.w = cvt_pk_bf16(b[2], b[3]);
                    *(u32x4*)(h + tok * DM + 512 + hh * 128 + cc) = w;
                    ss += __shfl_xor(ss, 16); ss += __shfl_xor(ss, 32); if (fq == 0) unsafeAtomicAdd(rssb + tok, ss); } }
        }
    }
};

__device__ __forceinline__ void transpose_job(LAS unsigned char* lds, const float* src, int Kd, int Nd, bf16_t* dst, int mode) {
    LAS bf16_t* T = (LAS bf16_t*)lds;
    const int tid = threadIdx.x, nkt = Kd / 64, nnt = Nd / 64, ntile = nkt * nnt;
    for (int it = blockIdx.x; it < ntile; it += gridDim.x) {
        const int kt = it % nkt, ntl = it / nkt, k0 = kt * 64, n0 = ntl * 64;
        int n0d = n0;
        if (mode == 1) { const int j = n0 < DFF ? n0 : n0 - DFF; n0d = (j >> 7) * 256 + (j & 127) + (n0 < DFF ? 0 : 128); }
        __syncthreads();
#pragma unroll
        for (int i = 0; i < 8; ++i) { const int e = tid + i * 512, kl = e >> 6, nl = e & 63; T[nl * 66 + kl] = f2bf(src[(size_t)(k0 + kl) * Nd + n0 + nl]); }
        __syncthreads();
#pragma unroll
        for (int i = 0; i < 4; ++i) { const int e = tid + i * 512, nl = e >> 5, kp = e & 31; *(unsigned*)(dst + (size_t)(n0d + nl) * Kd + k0 + 2 * kp) = *(const LAS unsigned*)(T + nl * 66 + 2 * kp); }
    }
    __syncthreads();
}
__device__ __forceinline__ void s5_pow(float lre, float lim, double dt, int tau, double& er, double& ei) {
    const double m = exp((double)lre * dt * (double)tau), a = (double)lim * dt * (double)tau; double s, c; sincos(a, &s, &c); er = m * c; ei = m * s;
}
__device__ __forceinline__ void s5_f(float lre, float lim, double dt, double& fr, double& fi) {
    double ar, ai; s5_pow(lre, lim, dt, 1, ar, ai); const double nr = ar - 1.0, ni = ai, lr = (double)lre, li = (double)lim, den = lr * lr + li * li;
    fr = (nr * lr + ni * li) / den; fi = (ni * lr - nr * li) / den;
}

__device__ __forceinline__ void phase0(const P& p, LAS unsigned char* lds) {
    const int tid = threadIdx.x, G = gridDim.x, bid = blockIdx.x;
    unsigned char* ws = p.ws;
    {
        LAS float* S = (LAS float*)lds;
        float* MOD = (float*)(ws + WS_MOD);
        const float* wada = p.in[4]; const float* bada = p.in[5];
        for (int it = bid; it < 576; it += G) {
            const int cb = it % 36, kc = it / 36;
            __syncthreads();
            for (int e = tid; e < 1024; e += 512) { const int b = e >> 6, k = e & 63; const float* c = b < 8 ? p.in[2] + b * 1024 : p.in[3] + (b - 8) * 1024; const float v = c[kc * 64 + k]; S[e] = silu_f(v); }
            __syncthreads();
            const int col = cb * 256 + (tid & 255), kh = tid >> 8;
            float acc[16];
#pragma unroll
            for (int b = 0; b < 16; ++b) acc[b] = 0.f;
#pragma unroll 8
            for (int kk = 0; kk < 32; ++kk) { const int k = kh * 32 + kk; const float w = wada[(size_t)(kc * 64 + k) * 9216 + col];
#pragma unroll
                for (int b = 0; b < 16; ++b) acc[b] += S[b * 64 + k] * w; }
            if (kc == 0 && kh == 0) { const float bb = bada[col];
#pragma unroll
                for (int b = 0; b < 16; ++b) acc[b] += bb; }
#pragma unroll
            for (int b = 0; b < 16; ++b) unsafeAtomicAdd(MOD + b * 9216 + col, acc[b]);
        }
        __syncthreads();
    }
    transpose_job(lds, p.in[7], DM, NIN, (bf16_t*)(ws + WS_WIN1), 1);
    transpose_job(lds, p.in[35], DM, NIN, (bf16_t*)(ws + WS_WIN2), 1);
    transpose_job(lds, p.in[8], DFF, DM, (bf16_t*)(ws + WS_WOUT1), 0);
    transpose_job(lds, p.in[36], DFF, DM, (bf16_t*)(ws + WS_WOUT2), 0);
    transpose_job(lds, p.in[10], DM, NMIX, (bf16_t*)(ws + WS_WMIXIN), 0);
    transpose_job(lds, p.in[26], 512, 512, (bf16_t*)(ws + WS_WGLU), 0);
    transpose_job(lds, p.in[33], DM, DM, (bf16_t*)(ws + WS_WMIXOUT), 0);
    {
        bf16_t* wbd = (bf16_t*)(ws + WS_WBD); const float* wsp = p.in[29];
        for (int i = bid * 512 + tid; i < 512 * 64; i += G * 512) {
            const int kg = i & 63, row = i >> 6, h = row >> 7, q = row & 127, col0 = kg * 8, hp = col0 >> 7, k0 = col0 & 127;
            u32x4 w = (u32x4){0u, 0u, 0u, 0u};
            if (h == hp) { const float* s = wsp + ((size_t)h * 128 + q) * 128 + k0; const f32x4 a = *(const f32x4*)s, b = *(const f32x4*)(s + 4);
                w.x = cvt_pk_bf16(a[0], a[1]); w.y = cvt_pk_bf16(a[2], a[3]); w.z = cvt_pk_bf16(b[0], b[1]); w.w = cvt_pk_bf16(b[2], b[3]); }
            *(u32x4*)(wbd + (size_t)row * 512 + col0) = w;
        }
    }
    {
        LAS float* EBr = (LAS float*)lds; LAS float* EBi = EBr + 1024;
        float* klag = (float*)(ws + WS_KLAG);
        for (int it = bid; it < NGRP * 63; it += G) {
            const int g = it / 63, l = it % 63;
            float accv = 0.f;
            for (int dir = 0; dir < 2; ++dir) {
                if ((dir == 0 && l > 31) || (dir == 1 && l < 31)) continue;
                const int tau = dir == 0 ? 31 - l : l - 31; const int o = dir * 7;
                const float* lre = p.in[11 + o]; const float* lim = p.in[12 + o]; const float* lst = p.in[13 + o];
                const float* bre = p.in[14 + o]; const float* bim = p.in[15 + o]; const float* cre = p.in[16 + o]; const float* cim = p.in[17 + o];
                const double dt = exp((double)lst[g]);
                __syncthreads();
                for (int idx = tid; idx < 1024; idx += 512) { const int pp = idx >> 4, hp = idx & 15; const float a = lre[g * 64 + pp], b = lim[g * 64 + pp];
                    double er, ei, fr, fi; s5_pow(a, b, dt, tau, er, ei); s5_f(a, b, dt, fr, fi);
                    const double gr = er * fr - ei * fi, gi = er * fi + ei * fr; const double br = bre[(g * 64 + pp) * 16 + hp], bi = bim[(g * 64 + pp) * 16 + hp];
                    EBr[idx] = (float)(gr * br - gi * bi); EBi[idx] = (float)(gr * bi + gi * br); }
                __syncthreads();
                if (tid < 256) { const int h = tid >> 4, hp = tid & 15; const float* cr = cre + (g * 16 + h) * 64; const float* ci = cim + (g * 16 + h) * 64; float s = 0.f;
                    for (int pp = 0; pp < 64; ++pp) s += cr[pp] * EBr[pp * 16 + hp] - ci[pp] * EBi[pp * 16 + hp];
                    accv += s; }
            }
            if (tid < 256) { const int h = tid >> 4, hp = tid & 15; if (l == 31 && h == hp) accv += p.in[25][g * 16 + h]; klag[((size_t)g * 63 + l) * 256 + tid] = accv; }
        }
        __syncthreads();
    }
    {
        bf16_t* w1s = (bf16_t*)(ws + WS_W1S); bf16_t* w2s = (bf16_t*)(ws + WS_W2S);
        for (int it = bid; it < NGRP * 2 * 32; it += G) {
            const int t = it & 31, dir = (it >> 5) & 1, g = it >> 6; const int o = dir * 7;
            const int pp = tid & 63, hh = tid >> 6;
            const float a = p.in[11 + o][g * 64 + pp], b = p.in[12 + o][g * 64 + pp]; const double dt = exp((double)p.in[13 + o][g]);
            double e1r, e1i, e2r, e2i, fr, fi;
            s5_pow(a, b, dt, dir == 0 ? 31 - t : t, e1r, e1i); s5_pow(a, b, dt, dir == 0 ? t + 1 : 32 - t, e2r, e2i); s5_f(a, b, dt, fr, fi);
            const double gr = e1r * fr - e1i * fi, gi = e1r * fi + e1i * fr;
#pragma unroll
            for (int j = 0; j < 2; ++j) { const int h = 2 * hh + j;
                const double br = p.in[14 + o][(g * 64 + pp) * 16 + h], bi = p.in[15 + o][(g * 64 + pp) * 16 + h];
                w1s[((size_t)g * 256 + dir * 128 + pp) * 512 + t * 16 + h] = f2bf((float)(gr * br - gi * bi));
                w1s[((size_t)g * 256 + dir * 128 + 64 + pp) * 512 + t * 16 + h] = f2bf((float)(gr * bi + gi * br));
                const double cr = p.in[16 + o][(g * 16 + h) * 64 + pp], ci = p.in[17 + o][(g * 16 + h) * 64 + pp];
                w2s[((size_t)g * 512 + t * 16 + h) * KS2 + 512 + dir * 128 + pp] = f2bf((float)(cr * e2r - ci * e2i));
                w2s[((size_t)g * 512 + t * 16 + h) * KS2 + 512 + dir * 128 + 64 + pp] = f2bf((float)(-(cr * e2i + ci * e2r))); }
        }
    }
}

__device__ __forceinline__ void pass_modnorm_in(const P& p, const float* gain, int shidx) {
    const int lane = threadIdx.x & 63, wave = threadIdx.x >> 6;
    const float* MOD = (const float*)(p.ws + WS_MOD); bf16_t* H = (bf16_t*)(p.ws + WS_H);
    const int stride = gridDim.x * 8;
    for (int row = blockIdx.x * 8 + wave; row < MT; row += 2 * stride) {
        const int row2 = row + stride;
        const bool has2 = row2 < MT;
        const float* s0 = row < MP ? p.in[0] + (size_t)row * DM : p.in[1] + (size_t)(row - MP) * DM;
        const int r2 = has2 ? row2 : row;
        const float* s1 = r2 < MP ? p.in[0] + (size_t)r2 * DM : p.in[1] + (size_t)(r2 - MP) * DM;
        f32x4 v[4], w[4]; float ss = 0.f, tt = 0.f;
#pragma unroll
        for (int i = 0; i < 4; ++i) { v[i] = *(const f32x4*)(s0 + i * 256 + lane * 4); w[i] = *(const f32x4*)(s1 + i * 256 + lane * 4); }
#pragma unroll
        for (int i = 0; i < 4; ++i) { ss += v[i][0] * v[i][0] + v[i][1] * v[i][1] + v[i][2] * v[i][2] + v[i][3] * v[i][3]; tt += w[i][0] * w[i][0] + w[i][1] * w[i][1] + w[i][2] * w[i][2] + w[i][3] * w[i][3]; }
        ss = wave_sum(ss); tt = wave_sum(tt);
        const float rs0 = rsqrtf(ss * (1.0f / DM) + EPS), rs1 = rsqrtf(tt * (1.0f / DM) + EPS);
        const float* sh0 = MOD + (size_t)batch_of_row(row) * 9216 + shidx * 1024; const float* sh1 = MOD + (size_t)batch_of_row(r2) * 9216 + shidx * 1024;
#pragma unroll
        for (int i = 0; i < 4; ++i) { const int c = i * 256 + lane * 4; const f32x4 g4 = *(const f32x4*)(gain + c);
            { const f32x4 s4 = *(const f32x4*)(sh0 + 1024 + c), h4 = *(const f32x4*)(sh0 + c); const f32x4 o = v[i] * rs0 * g4 * (s4 + 1.0f) + h4; u32x2 q; q.x = cvt_pk_bf16(o[0], o[1]); q.y = cvt_pk_bf16(o[2], o[3]); *(u32x2*)(H + (size_t)row * DM + c) = q; }
            if (has2) { const f32x4 s4 = *(const f32x4*)(sh1 + 1024 + c), h4 = *(const f32x4*)(sh1 + c); const f32x4 o = w[i] * rs1 * g4 * (s4 + 1.0f) + h4; u32x2 q; q.x = cvt_pk_bf16(o[0], o[1]); q.y = cvt_pk_bf16(o[2], o[3]); *(u32x2*)(H + (size_t)row2 * DM + c) = q; } }
    }
}
__device__ __forceinline__ void pass_shw(const P& p, LAS unsigned char* lds, const bf16_t* Wt, int N, int shidx, float* out) {
    const int tid = threadIdx.x, lane = tid & 63, wave = tid >> 6;
    LAS float* S = (LAS float*)lds;
    const float* MOD = (const float*)(p.ws + WS_MOD);
    __syncthreads();
    for (int e = tid; e < 16 * 256; e += 512) { const int b = e >> 8, k4 = e & 255; *(LAS f32x4*)(S + b * 1024 + k4 * 4) = *(const f32x4*)(MOD + (size_t)b * 9216 + shidx * 1024 + k4 * 4); }
    __syncthreads();
    for (int n = blockIdx.x * 8 + wave; n < N; n += gridDim.x * 8) {
        float w[16];
#pragma unroll
        for (int j = 0; j < 4; ++j) { const u32x2 q = *(const u32x2*)(Wt + (size_t)n * DM + j * 256 + lane * 4); w[j * 4] = bflo(q.x); w[j * 4 + 1] = bfhi(q.x); w[j * 4 + 2] = bflo(q.y); w[j * 4 + 3] = bfhi(q.y); }
        float mine = 0.f;
#pragma unroll 1
        for (int b = 0; b < 16; ++b) { float a = 0.f;
#pragma unroll
            for (int j = 0; j < 4; ++j) { const f32x4 s4 = *(const LAS f32x4*)(S + b * 1024 + j * 256 + lane * 4); a += w[j * 4] * s4[0] + w[j * 4 + 1] * s4[1] + w[j * 4 + 2] * s4[2] + w[j * 4 + 3] * s4[3]; }
            a = wave_sum(a); if (lane == b) mine = a; }
        if (lane < 16) out[(size_t)lane * N + n] = mine;
    }
    __syncthreads();
}
__device__ __forceinline__ void pass_final(const P& p) {
    const int lane = threadIdx.x & 63, wave = threadIdx.x >> 6; const float* gain = p.in[37];
    for (int row = blockIdx.x * 8 + wave; row < MT; row += gridDim.x * 8) {
        float* src = p.out + (size_t)row * DM; f32x4 v[4]; float ss = 0.f;
#pragma unroll
        for (int i = 0; i < 4; ++i) { v[i] = *(const f32x4*)(src + i * 256 + lane * 4); ss += v[i][0] * v[i][0] + v[i][1] * v[i][1] + v[i][2] * v[i][2] + v[i][3] * v[i][3]; }
        ss = wave_sum(ss); const float rstd = rsqrtf(ss * (1.0f / DM) + EPS);
#pragma unroll
        for (int i = 0; i < 4; ++i) { const int c = i * 256 + lane * 4; *(f32x4*)(src + c) = v[i] * rstd * *(const f32x4*)(gain + c); }
    }
}
__device__ __forceinline__ void fill_kmat(const P& p) {
    const float* klag = (const float*)(p.ws + WS_KLAG); bf16_t* w2s = (bf16_t*)(p.ws + WS_W2S);
    for (int i = blockIdx.x * 512 + threadIdx.x; i < NGRP * 512 * 64; i += gridDim.x * 512) {
        const int kg = i & 63, n = (i >> 6) & 511, g = i >> 15, t = n >> 4, h = n & 15, s = kg >> 1, hp0 = (kg & 1) * 8, l = s - t + 31;
        const float* src = klag + ((size_t)g * 63 + l) * 256 + h * 16 + hp0; const f32x4 a = *(const f32x4*)src, b = *(const f32x4*)(src + 4);
        u32x4 w; w.x = cvt_pk_bf16(a[0], a[1]); w.y = cvt_pk_bf16(a[2], a[3]); w.z = cvt_pk_bf16(b[0], b[1]); w.w = cvt_pk_bf16(b[2], b[3]);
        *(u32x4*)(w2s + ((size_t)g * 512 + n) * KS2 + s * 16 + hp0) = w;
    }
}
__device__ __forceinline__ void pass_ln_transpose(const P& p, LAS unsigned char* lds) {
    const int tid = threadIdx.x, lane = tid & 63, wave = tid >> 6;
    LAS float* ST = (LAS float*)lds;
    LAS bf16_t* T = (LAS bf16_t*)(lds + 1024);
    const bf16_t* vg = (const bf16_t*)(p.ws + WS_VG); bf16_t* vt = (bf16_t*)(p.ws + WS_VT);
    const float* lg = p.in[27]; const float* lb = p.in[28];
    for (int bn = blockIdx.x; bn < MT / 128; bn += gridDim.x) {
        __syncthreads();
        for (int tt = 0; tt < 16; ++tt) { const int k = wave * 16 + tt; const u32x4 a = *(const u32x4*)(vg + ((size_t)bn * 128 + k) * 512 + lane * 8);
            const float x[8] = {bflo(a.x), bfhi(a.x), bflo(a.y), bfhi(a.y), bflo(a.z), bfhi(a.z), bflo(a.w), bfhi(a.w)};
            float s = 0.f, q = 0.f;
#pragma unroll
            for (int j = 0; j < 8; ++j) { s += x[j]; q += x[j] * x[j]; }
            s = wave_sum(s); q = wave_sum(q); const float mu = s * (1.0f / 512), var = fmaxf(q * (1.0f / 512) - mu * mu, 0.f);
            if (lane == 0) { ST[k * 2] = mu; ST[k * 2 + 1] = rsqrtf(var + EPS); } }
        __syncthreads();
        for (int h = 0; h < 4; ++h) {
#pragma unroll
            for (int i = 0; i < 4; ++i) { const int idx = tid + i * 512, k = idx >> 4, c0 = (idx & 15) * 8;
                const u32x4 a = *(const u32x4*)(vg + ((size_t)bn * 128 + k) * 512 + h * 128 + c0); const float mu = ST[k * 2], rs = ST[k * 2 + 1];
                const float x[8] = {bflo(a.x), bfhi(a.x), bflo(a.y), bfhi(a.y), bflo(a.z), bfhi(a.z), bflo(a.w), bfhi(a.w)};
                const f32x4 g0 = *(const f32x4*)(lg + h * 128 + c0), g1 = *(const f32x4*)(lg + h * 128 + c0 + 4), b0 = *(const f32x4*)(lb + h * 128 + c0), b1 = *(const f32x4*)(lb + h * 128 + c0 + 4);
#pragma unroll
                for (int j = 0; j < 4; ++j) { T[(c0 + j) * 136 + k] = f2bf((x[j] - mu) * rs * g0[j] + b0[j]); T[(c0 + 4 + j) * 136 + k] = f2bf((x[4 + j] - mu) * rs * g1[j] + b1[j]); } }
            __syncthreads();
#pragma unroll
            for (int i = 0; i < 4; ++i) { const int idx = tid + i * 512, c = idx >> 4, kg = idx & 15;
                *(u32x4*)(vt + (((size_t)bn * 128 + c) * 4 + h) * 128 + kg * 8) = *(const LAS u32x4*)(T + c * 136 + kg * 8); }
            __syncthreads();
        }
    }
}
__device__ __forceinline__ void pass_chunk_scan(const P& p) {
    const float* sloc = (const float*)(p.ws + WS_SLOC); bf16_t* ug = (bf16_t*)(p.ws + WS_UG);
    for (int T = blockIdx.x * 512 + threadIdx.x; T < 16 * NGRP * 128; T += gridDim.x * 512) {
        const int j = T & 127, dir = j >> 6, pp = j & 63, g = (T >> 7) & 31, b = T >> 12;
        const int cb = b < 8 ? b * 64 : 512 + (b - 8) * 256, nc = b < 8 ? 64 : 256; const int o = dir * 7;
        const double dt = exp((double)p.in[13 + o][g]); double er, ei; s5_pow(p.in[11 + o][g * 64 + pp], p.in[12 + o][g * 64 + pp], dt, TCH, er, ei);
        const float ar = (float)er, ai = (float)ei;
        const float* lp = sloc + ((size_t)g * NCHK + cb) * 256 + dir * 128 + pp;
        bf16_t* up = ug + ((size_t)g * NCHK + cb) * KS2 + 512 + dir * 128 + pp;
        float sr = 0.f, si = 0.f;
        for (int c0 = 0; c0 < nc; c0 += 8) {
            float lr[8], li[8];
#pragma unroll
            for (int q = 0; q < 8; ++q) { const int c = dir == 0 ? c0 + q : nc - 1 - (c0 + q); lr[q] = lp[(size_t)c * 256]; li[q] = lp[(size_t)c * 256 + 64]; }
#pragma unroll
            for (int q = 0; q < 8; ++q) { const int c = dir == 0 ? c0 + q : nc - 1 - (c0 + q);
                up[(size_t)c * KS2] = f2bf(sr); up[(size_t)c * KS2 + 64] = f2bf(si);
                const float nr = ar * sr - ai * si + lr[q], ni = ar * si + ai * sr + li[q]; sr = nr; si = ni; }
        }
    }
}

__global__ void __launch_bounds__(512, 2) mega(P p) {
    extern __shared__ __attribute__((aligned(16))) unsigned char lds_raw[];
    LAS unsigned char* lds = (LAS unsigned char*)lds_raw;
    cg::grid_group grid = cg::this_grid();
    const int lo = p.ph_lo, hi = p.ph_hi, G = gridDim.x, bid = blockIdx.x;
    unsigned char* ws = p.ws;
    const float* MOD = (const float*)(ws + WS_MOD);
    bf16_t* H = (bf16_t*)(ws + WS_H); bf16_t* HID = (bf16_t*)(ws + WS_HID);
    bf16_t* UG = (bf16_t*)(ws + WS_UG); bf16_t* UGM = (bf16_t*)(ws + WS_UGM); bf16_t* VG = (bf16_t*)(ws + WS_VG); bf16_t* VT = (bf16_t*)(ws + WS_VT);
    float* SLOC = (float*)(ws + WS_SLOC); bf16_t* Y = (bf16_t*)(ws + WS_SLOC); bf16_t* H2 = (bf16_t*)(ws + WS_H2);
    float* RSS1 = (float*)(ws + WS_RSS1); float* RSS2 = (float*)(ws + WS_RSS2); float* RSSA = (float*)(ws + WS_RSSA); float* RSSB = (float*)(ws + WS_RSSB);
#ifndef PHMASK
#define PHMASK 0xFFFF
#endif
#define IN(k) (((PHMASK >> (k)) & 1) && lo <= (k) && (k) < hi)
#define SYNC(k) do { if (IN(k) && IN((k) + 1)) grid.sync(); } while (0)
    if (IN(0)) phase0(p, lds);
    SYNC(0);
    if (IN(1)) { pass_modnorm_in(p, p.in[6], 0); fill_kmat(p);
        pass_shw(p, lds, (const bf16_t*)(ws + WS_WMIXIN), NMIX, 3, (float*)(ws + WS_SHW2)); pass_shw(p, lds, (const bf16_t*)(ws + WS_WIN2), NIN, 6, (float*)(ws + WS_SHW3)); }
    SYNC(1);
    if (IN(2)) { pg8::Gemm g{H, (const bf16_t*)(ws + WS_WIN1), DM, DM, DM, 0, 0}; pg8::Order S; S.init(MT / 256, NIN / 256, 1, G, bid); EpiSwiglu<false> E{HID, nullptr, nullptr}; pg8::gemm_phase(lds, g, S, E); }
    SYNC(2);
    if (IN(3)) { pg8::Gemm g{HID, (const bf16_t*)(ws + WS_WOUT1), DFF, DFF, DFF, 0, 0}; pg8::Order S; S.init(MT / 256, DM / 256, 1, G, bid);
        EpiResid<true, false, true> E{p.in[0], p.in[1], p.out, MOD + 2 * 1024, H, p.in[9], MOD + 4 * 1024, RSS1, nullptr, nullptr}; pg8::gemm_phase(lds, g, S, E); }
    SYNC(3);
    if (IN(4)) { pg8::Gemm g{H, (const bf16_t*)(ws + WS_WMIXIN), DM, DM, DM, 0, 0}; pg8::Order S; S.init(MT / 256, NMIX / 256, 1, G, bid); EpiMixIn E{UG, UGM, VG, RSS1, (const float*)(ws + WS_SHW2)}; pg8::gemm_phase(lds, g, S, E); }
    SYNC(4);
    if (IN(5)) { pass_ln_transpose(p, lds);
        pg8::Gemm g{UG, (const bf16_t*)(ws + WS_W1S), KS2, 512, 512, (size_t)NCHK * KS2, (size_t)256 * 512}; pg8::Order S; S.init(NCHK / 256, 1, NGRP, G, bid); EpiS1 E{SLOC}; pg8::gemm_phase(lds, g, S, E); }
    SYNC(5);
    if (IN(6)) { pass_chunk_scan(p);
        pg8::Gemm g{(const bf16_t*)(ws + WS_WBD), VT, 512, 512, 512, 0, 0}; pg8::Order S; S.init(2, MT / 256, 1, G, bid); EpiSpatial E{UGM, p.in[30], H, p.in[32], RSSB}; pg8::gemm_phase(lds, g, S, E); }
    SYNC(6);
    if (IN(7)) { pg8::Gemm g{UG, (const bf16_t*)(ws + WS_W2S), KS2, KS2, KS2, (size_t)NCHK * KS2, (size_t)512 * KS2}; pg8::Order S; S.init(NCHK / 256, 2, NGRP, G, bid); EpiS2 E{Y}; pg8::gemm_phase(lds, g, S, E); }
    SYNC(7);
    if (IN(8)) { pg8::Gemm g{Y, (const bf16_t*)(ws + WS_WGLU), 512, 512, 512, 0, 0}; pg8::Order S; S.init(MT / 256, 2, 1, G, bid); EpiGlu E{Y, H, p.in[31], RSSA}; pg8::gemm_phase(lds, g, S, E); }
    SYNC(8);
    if (IN(9)) { pg8::Gemm g{H, (const bf16_t*)(ws + WS_WMIXOUT), DM, DM, DM, 0, 0}; pg8::Order S; S.init(MT / 256, DM / 256, 1, G, bid);
        EpiResid<true, true, false> E{p.out, p.out + (size_t)MP * DM, p.out, MOD + 5 * 1024, H2, p.in[34], MOD + 7 * 1024, RSS2, RSSA, RSSB}; pg8::gemm_phase(lds, g, S, E); }
    SYNC(9);
    if (IN(10)) { pg8::Gemm g{H2, (const bf16_t*)(ws + WS_WIN2), DM, DM, DM, 0, 0}; pg8::Order S; S.init(MT / 256, NIN / 256, 1, G, bid); EpiSwiglu<true> E{HID, RSS2, (const float*)(ws + WS_SHW3)}; pg8::gemm_phase(lds, g, S, E); }
    SYNC(10);
    if (IN(11)) { pg8::Gemm g{HID, (const bf16_t*)(ws + WS_WOUT2), DFF, DFF, DFF, 0, 0}; pg8::Order S; S.init(MT / 256, DM / 256, 1, G, bid);
        EpiResid<false, false, true> E{p.out, p.out + (size_t)MP * DM, p.out, MOD + 8 * 1024, nullptr, nullptr, nullptr, nullptr, nullptr, nullptr}; pg8::gemm_phase(lds, g, S, E); }
    SYNC(11);
    if (IN(12)) pass_final(p);
#undef IN
#undef SYNC
}

extern "C" void kernel_launch(void* const* d_in, const int* in_sizes, int n_in, void* d_out, int out_size, void* d_ws, size_t ws_size, hipStream_t stream) {
    static int grid = 0;
    if (grid == 0) {
        if (n_in != 38 || out_size != MT * DM || ws_size < WS_END) { fprintf(stderr, "kernel_launch: unexpected shapes: n_in %d out %d ws %zu (need %zu)\n", n_in, out_size, ws_size, (size_t)WS_END); grid = -1; return; }
        int dev = 0, cus = 0, per_cu = 0;
        (void)hipGetDevice(&dev); (void)hipDeviceGetAttribute(&cus, hipDeviceAttributeMultiprocessorCount, dev);
        if (hipFuncSetAttribute((const void*)mega, hipFuncAttributeMaxDynamicSharedMemorySize, LDS_BYTES) != hipSuccess) { fprintf(stderr, "kernel_launch: hipFuncSetAttribute failed\n"); grid = -1; return; }
        (void)hipOccupancyMaxActiveBlocksPerMultiprocessor(&per_cu, (const void*)mega, 512, LDS_BYTES);
        if (per_cu < 1) per_cu = 1;
        grid = cus * 1;
        (void)hipGetLastError();
        fprintf(stderr, "kernel_launch: cus %d per_cu %d grid %d ws need %zu have %zu\n", cus, per_cu, grid, (size_t)WS_END, ws_size);
    }
    if (grid < 0) return;
    (void)hipMemsetAsync((char*)d_ws + WS_MOD, 0, ZERO_BYTES, stream);
    P p{};
    for (int i = 0; i < 38; ++i) p.in[i] = (const float*)d_in[i];
    p.out = (float*)d_out; p.ws = (unsigned char*)d_ws;
#if N_LAUNCH_MODE == 0
    p.ph_lo = 0; p.ph_hi = NPHASE;
    void* args[] = {&p};
    hipError_t e = hipLaunchCooperativeKernel((const void*)mega, dim3(grid), dim3(512), args, LDS_BYTES, stream);
    if (e != hipSuccess) fprintf(stderr, "cooperative launch failed: %s (grid %d)\n", hipGetErrorString(e), grid);
#else
    for (int k = 0; k < NPHASE; ++k) { p.ph_lo = k; p.ph_hi = k + 1; hipLaunchKernelGGL(mega, dim3(grid), dim3(512), LDS_BYTES, stream, p); }
#endif
}
```

```cpp
#include <hip/hip_runtime.h>
#include <hip/hip_cooperative_groups.h>
#include <cstdio>
namespace cg = cooperative_groups;

#define LAS __attribute__((address_space(3)))
typedef unsigned short bf16_t;
typedef short bf16x8 __attribute__((ext_vector_type(8)));
typedef float f32x4 __attribute__((ext_vector_type(4)));
typedef unsigned u32x4 __attribute__((ext_vector_type(4)));
typedef unsigned u32x2 __attribute__((ext_vector_type(2)));

#ifndef N_LAUNCH_MODE
#define N_LAUNCH_MODE 0
#endif

constexpr int MT = 81920;
constexpr int MP = 16384;
constexpr int DM = 1024, DFF = 2816, NIN = 5632, NMIX = 1536;
constexpr int NGRP = 32, TCH = 32, NCHK = MT / TCH  , KS2 = 768;
constexpr float EPS = 1e-6f;
constexpr int NPHASE = 13;

constexpr size_t al256(size_t x) { return (x + 255) & ~(size_t)255; }
constexpr size_t WS_MOD = 0;
constexpr size_t MOD_BYTES = 16 * 9216 * 4;
constexpr size_t WS_RSS1 = WS_MOD + MOD_BYTES;
constexpr size_t WS_RSS2 = WS_RSS1 + (size_t)MT * 4;
constexpr size_t WS_RSSA = WS_RSS2 + (size_t)MT * 4;
constexpr size_t WS_RSSB = WS_RSSA + (size_t)MT * 4;
constexpr size_t WS_BAR = WS_RSSB + (size_t)MT * 4;
constexpr size_t ZERO_BYTES = WS_BAR + 3456 * 4;
constexpr size_t WS_SHW2 = ZERO_BYTES;
constexpr size_t WS_SHW3 = WS_SHW2 + 16 * 1536 * 4;
constexpr size_t WS_WIN1 = al256(WS_SHW3 + 16 * 5632 * 4);
constexpr size_t WS_WIN2 = WS_WIN1 + (size_t)NIN * DM * 2;
constexpr size_t WS_WOUT1 = WS_WIN2 + (size_t)NIN * DM * 2;
constexpr size_t WS_WOUT2 = WS_WOUT1 + (size_t)DM * DFF * 2;
constexpr size_t WS_WMIXIN = WS_WOUT2 + (size_t)DM * DFF * 2;
constexpr size_t WS_WGLU = WS_WMIXIN + (size_t)NMIX * DM * 2;
constexpr size_t WS_WMIXOUT = WS_WGLU + 512 * 512 * 2;
constexpr size_t WS_WBD = WS_WMIXOUT + (size_t)DM * DM * 2;
constexpr size_t WS_KLAG = WS_WBD + 512 * 512 * 2;
constexpr size_t WS_W1S = WS_KLAG + (size_t)NGRP * 63 * 256 * 4;
constexpr size_t WS_W2S = WS_W1S + (size_t)NGRP * 256 * 512 * 2;
constexpr size_t WS_H = WS_W2S + (size_t)NGRP * 512 * KS2 * 2;
constexpr size_t WS_H2 = WS_H + (size_t)MT * DM * 2;
constexpr size_t WS_R = WS_H2 + (size_t)MT * DM * 2;
constexpr size_t WS_HID = WS_R;
constexpr size_t WS_UG = WS_R;
constexpr size_t WS_UGM = WS_UG + (size_t)NGRP * NCHK * KS2 * 2;
constexpr size_t WS_VG = WS_UGM + (size_t)MT * 512 * 2;
constexpr size_t WS_VT = WS_VG + (size_t)MT * 512 * 2;
constexpr size_t WS_SLOC = WS_VT + (size_t)MT * 512 * 2;
constexpr size_t WS_END = WS_R + (size_t)MT * DFF * 2;
static_assert(WS_SLOC + (size_t)NGRP * NCHK * 256 * 4 <= WS_END, "mixer buffers must fit the HID region");

constexpr int LDS_STAGE = 131072;
constexpr int LDS_BYTES = LDS_STAGE + 16;

struct P { const float* in[38]; float* out; unsigned char* ws; int ph_lo, ph_hi; };

__device__ __forceinline__ unsigned cvt_pk_bf16(float lo, float hi) { unsigned r; asm volatile("v_cvt_pk_bf16_f32 %0, %1, %2" : "=v"(r) : "v"(lo), "v"(hi)); return r; }
__device__ __forceinline__ bf16_t f2bf(float f) { return (bf16_t)(cvt_pk_bf16(f, 0.f) & 0xffffu); }
__device__ __forceinline__ float bflo(unsigned w) { return __uint_as_float(w << 16); }
__device__ __forceinline__ float bfhi(unsigned w) { return __uint_as_float(w & 0xffff0000u); }
__device__ __forceinline__ float wave_sum(float v) {
#pragma unroll
    for (int o = 32; o; o >>= 1) v += __shfl_xor(v, o);
    return v;
}
__device__ __forceinline__ float sigmoid_f(float a) { return __builtin_amdgcn_rcpf(1.f + __expf(-a)); }
__device__ __forceinline__ float gelu_f(float x) { return x * sigmoid_f(1.5957691216f * (x + 0.044715f * x * x * x)); }
__device__ __forceinline__ float silu_f(float x) { return x * sigmoid_f(x); }
__device__ __forceinline__ int batch_of_row(int row) { return row < MP ? (row >> 11) : 8 + ((row - MP) >> 13); }
__device__ __forceinline__ int batch_of_tile(int pm) { return pm < 64 ? (pm >> 3) : 8 + ((pm - 64) >> 5); }

namespace pg8 {
constexpr int BM = 256, BK = 64, HALF = 128, HTB = HALF * BK * 2, NXCD = 8, WGM = 8;
__device__ __forceinline__ int lds_byte(int r, int c) { const int st = (r >> 4) * 2 + (c >> 5), rr = r & 15, cc = c & 31, ob = rr * 64 + cc * 2; return st * 1024 + (ob ^ (((ob >> 9) & 1) << 5)); }
__device__ __forceinline__ void stage_rc(int b, int& R, int& C) { const int st = b / 1024, sb = b % 1024, swz = sb ^ (((sb >> 9) & 1) << 5); R = (st >> 1) * 16 + swz / 64; C = (st & 1) * 32 + (swz % 64) / 2; }
__device__ __forceinline__ int perm32(int rho) { const int n = rho >> 4, i = rho & 15; return 8 * (i >> 2) + 4 * n + (i & 3); }

__device__ __forceinline__ const char* uni_ptr(const char* q) { const unsigned long long v = (unsigned long long)q; const unsigned lo = __builtin_amdgcn_readfirstlane((unsigned)v), hi = __builtin_amdgcn_readfirstlane((unsigned)(v >> 32)); return (const char*)(((unsigned long long)hi << 32) | lo); }
struct Unit { int pm, pn, g; };
struct Gemm { const bf16_t* A; const bf16_t* Bt; int lda, ldb, K; size_t gsA, gsB; int amode; };
struct Order {
    int nM, nN, ntot, G, c;
    __device__ void init(int nM_, int nN_, int nG_, int G_, int c_) { nM = nM_; nN = nN_; ntot = nM_ * nN_ * nG_; G = G_; c = c_; }
    __device__ bool next(int i, Unit& u) const {
        const long L = (long)i * G + c; if (L >= ntot) return false;
        int wgid = (int)L; { const int q = ntot / NXCD, r = ntot % NXCD, xcd = wgid % NXCD, off = wgid / NXCD; wgid = (xcd < r ? xcd * (q + 1) : r * (q + 1) + (xcd - r) * q) + off; }
        const int per = nM * nN; u.g = wgid / per; const int w = wgid - u.g * per;
        const int nig = WGM * nN, gid = w / nig, fm = gid * WGM, gsz = (nM - fm) < WGM ? (nM - fm) : WGM;
        u.pm = fm + ((w % nig) % gsz); u.pn = (w % nig) / gsz; return true;
    }
};

template <class Epi>
__device__ __forceinline__ void gemm_phase(LAS unsigned char* lds, const Gemm g, const Order& S, const Epi& E) {
    int tid_ = threadIdx.x; asm volatile("" : "+v"(tid_));
    const int tid = tid_, wid = __builtin_amdgcn_readfirstlane(tid >> 6), lane = tid & 63, wr = wid >> 2, wc = wid & 3, fr = lane & 15, fq = lane >> 4;
    const int K = g.K, nt = K / BK;
    unsigned voffA[2], voffB[2];
#pragma unroll
    for (int i = 0; i < 2; ++i) { int R, C; stage_rc(tid * 16 + i * 8192, R, C); const int Rb = Epi::PERM ? ((R & ~31) + perm32(R & 31)) : R;
        voffA[i] = g.amode ? (unsigned)((C >> 4) * (2560 * 512) + (R >> 5) * 512 + (R & 31) * 16 + (C & 15)) * 2u : (unsigned)(R * g.lda + C) * 2u; voffB[i] = (unsigned)(Rb * g.ldb + C) * 2u; }
    const size_t kstep = (size_t)(BK * 2), kstepA = g.amode ? (size_t)4 * 2560 * 512 * 2 : kstep;
    const size_t hstepA = g.amode ? (size_t)4 * 512 * 2 : (size_t)HALF * g.lda * 2, hstepB = (size_t)HALF * g.ldb * 2;
    const size_t tstepA = 2 * hstepA, tstepB = 2 * hstepB;
    const unsigned ldsw = (unsigned)wid * 1024u;
    const int aoff = lds_byte(wr * 64 + fr, fq * 8), boff = lds_byte(wc * 32 + fr, fq * 8);
#define PG8_SA(b, h) (((b) * 2 + (h)) * HTB)
#define PG8_SB(b, h) ((4 + (b) * 2 + (h)) * HTB)
#define PG8_STAGE(bufoff, gbase, voff) do { _Pragma("unroll") for (int _i = 0; _i < 2; ++_i) \
        __builtin_amdgcn_global_load_lds((const unsigned*)((const char*)(gbase) + (voff)[_i]), (LAS unsigned*)(lds + (bufoff) + ldsw + _i * 8192), 16, 0, 0); } while (0)
#define PG8_LDA(dst, b, h) do { _Pragma("unroll") for (int m = 0; m < 4; ++m) _Pragma("unroll") for (int k = 0; k < 2; ++k) dst[m][k] = *(const LAS bf16x8*)(lds + PG8_SA(b, h) + aoff + m * 2048 + k * 1024); } while (0)
#define PG8_LDB(dst, b, h) do { _Pragma("unroll") for (int n = 0; n < 2; ++n) _Pragma("unroll") for (int k = 0; k < 2; ++k) dst[n][k] = *(const LAS bf16x8*)(lds + PG8_SB(b, h) + boff + n * 2048 + k * 1024); } while (0)
#define PG8_MMA(ai, bj, At, Bt) do { __builtin_amdgcn_s_setprio(1); _Pragma("unroll") for (int m = 0; m < 4; ++m) _Pragma("unroll") for (int n = 0; n < 2; ++n) _Pragma("unroll") for (int k = 0; k < 2; ++k) \
        acc[ai][bj][m][n] = __builtin_amdgcn_mfma_f32_16x16x32_bf16(Bt[n][k], At[m][k], acc[ai][bj][m][n], 0, 0, 0); __builtin_amdgcn_s_setprio(0); } while (0)
#define PG8_WAIT_V(n) asm volatile("s_waitcnt vmcnt(" #n ")" ::: "memory")
#define PG8_WAIT_L(n) asm volatile("s_waitcnt lgkmcnt(" #n ")" ::: "memory")
#define PG8_BAR __builtin_amdgcn_s_barrier()
#define PG8_SCHED __builtin_amdgcn_sched_barrier(0)
#define PG8_BASEA(u) uni_ptr((const char*)g.A + ((size_t)(u).g * g.gsA) * 2 + (size_t)(u).pm * tstepA)
#define PG8_BASEB(u) uni_ptr((const char*)g.Bt + ((size_t)(u).g * g.gsB) * 2 + (size_t)(u).pn * tstepB)
    Unit cur, nxt; int ui = 0;
    if (!S.next(0, cur)) return;
    f32x4 acc[2][2][4][2];
#pragma unroll
    for (int a = 0; a < 2; ++a)
#pragma unroll
        for (int b = 0; b < 2; ++b)
#pragma unroll
            for (int m = 0; m < 4; ++m)
#pragma unroll
                for (int n = 0; n < 2; ++n) acc[a][b][m][n] = (f32x4){0.f, 0.f, 0.f, 0.f};
    bf16x8 At[4][2], B0[2][2], B1[2][2];
    const char* cA = PG8_BASEA(cur); const char* cB = PG8_BASEB(cur);
    PG8_STAGE(PG8_SB(0, 0), cB, voffB); PG8_STAGE(PG8_SA(0, 0), cA, voffA); PG8_STAGE(PG8_SB(0, 1), cB + hstepB, voffB); PG8_STAGE(PG8_SA(0, 1), cA + hstepA, voffA);
    if (wr == 1) PG8_BAR;
    PG8_WAIT_V(4); PG8_BAR;
    PG8_STAGE(PG8_SB(1, 0), cB + kstep, voffB); PG8_STAGE(PG8_SA(1, 0), cA + kstepA, voffA); PG8_STAGE(PG8_SB(1, 1), cB + hstepB + kstep, voffB);
    PG8_WAIT_V(6); PG8_BAR;
    for (;;) {
        const bool has_next = S.next(ui + 1, nxt);
        const char* nA = has_next ? PG8_BASEA(nxt) : cA; const char* nB = has_next ? PG8_BASEB(nxt) : cB;
        for (int t = 0; t < nt; t += 2) {
            const bool last = (t == nt - 2);
            const char* a1 = cA + (size_t)(t + 1) * kstepA;
            const char* a2 = last ? nA : cA + (size_t)(t + 2) * kstepA; const char* b2 = last ? nB : cB + (size_t)(t + 2) * kstep;
            const char* a3 = a2 + kstepA; const char* b3 = b2 + kstep;
            if constexpr (Epi::MIDSCALE) { if (t == 8) E.midscale(acc, cur, wr, fr); }
            PG8_LDB(B0, 0, 0); PG8_SCHED; PG8_LDA(At, 0, 0); PG8_STAGE(PG8_SA(1, 1), a1 + hstepA, voffA);
            PG8_WAIT_L(8); PG8_BAR; PG8_WAIT_L(0); PG8_MMA(0, 0, At, B0); PG8_BAR; PG8_SCHED;
            PG8_LDB(B1, 0, 1); PG8_STAGE(PG8_SB(0, 0), b2, voffB);
            PG8_BAR; PG8_WAIT_L(0); PG8_MMA(0, 1, At, B1); PG8_BAR;
            PG8_LDA(At, 0, 1); PG8_STAGE(PG8_SA(0, 0), a2, voffA);
            PG8_BAR; PG8_WAIT_L(0); PG8_MMA(1, 0, At, B0); PG8_BAR; PG8_SCHED;
            PG8_STAGE(PG8_SB(0, 1), b2 + hstepB, voffB);
            PG8_WAIT_V(6); PG8_BAR; PG8_MMA(1, 1, At, B1); PG8_BAR;
            PG8_LDB(B0, 1, 0); PG8_SCHED; PG8_LDA(At, 1, 0); PG8_STAGE(PG8_SA(0, 1), a2 + hstepA, voffA);
            PG8_WAIT_L(8); PG8_BAR; PG8_WAIT_L(0); PG8_MMA(0, 0, At, B0); PG8_BAR; PG8_SCHED;
            PG8_LDB(B1, 1, 1); PG8_STAGE(PG8_SB(1, 0), b3, voffB);
            PG8_BAR; PG8_WAIT_L(0); PG8_MMA(0, 1, At, B1); PG8_BAR;
            PG8_LDA(At, 1, 1); PG8_STAGE(PG8_SA(1, 0), a3, voffA);
            PG8_BAR; PG8_WAIT_L(0); PG8_MMA(1, 0, At, B0); PG8_BAR; PG8_SCHED;
            PG8_STAGE(PG8_SB(1, 1), b3 + hstepB, voffB);
            PG8_WAIT_V(6); PG8_BAR; PG8_MMA(1, 1, At, B1); PG8_BAR;
        }
        E(acc, cur, wr, wc, fr, fq);
        if (!has_next) break;
#pragma unroll
        for (int a = 0; a < 2; ++a)
#pragma unroll
            for (int b = 0; b < 2; ++b)
#pragma unroll
                for (int m = 0; m < 4; ++m)
#pragma unroll
                    for (int n = 0; n < 2; ++n) acc[a][b][m][n] = (f32x4){0.f, 0.f, 0.f, 0.f};
        cur = nxt; cA = nA; cB = nB; ++ui;
    }
    PG8_WAIT_V(0);
    if (wr == 0) PG8_BAR;
    PG8_BAR;
#undef PG8_SA
#undef PG8_SB
#undef PG8_STAGE
#undef PG8_LDA
#undef PG8_LDB
#undef PG8_MMA
#undef PG8_WAIT_V
#undef PG8_WAIT_L
#undef PG8_BAR
#undef PG8_SCHED
#undef PG8_BASEA
#undef PG8_BASEB
}
}
using pg8::Unit;
typedef const f32x4 (&AccRef)[2][2][4][2];

template <bool NORM>
struct EpiSwiglu {
    static constexpr bool PERM = true, MIDSCALE = false;
    bf16_t* hid; const float* rss; const float* shw;
    __device__ __forceinline__ void operator()(AccRef acc, const Unit& u, int wr, int wc, int fr, int fq) const {
        const int row0 = u.pm * 256 + wr * 64 + fr, col0 = u.pn * 128 + wc * 32 + 8 * fq;
        f32x4 sg0, sg1, su0, su1;
        float rsv[2][4];
        if (NORM) { const float* sp = shw + (size_t)batch_of_tile(u.pm) * NIN + u.pn * 256 + wc * 32 + 8 * fq; sg0 = *(const f32x4*)sp; sg1 = *(const f32x4*)(sp + 4); su0 = *(const f32x4*)(sp + 128); su1 = *(const f32x4*)(sp + 132);
            const float* rp = rss + row0;
#pragma unroll
            for (int ai = 0; ai < 2; ++ai)
#pragma unroll
                for (int m = 0; m < 4; ++m) rsv[ai][m] = rp[ai * 128 + m * 16];
#pragma unroll
            for (int ai = 0; ai < 2; ++ai)
#pragma unroll
                for (int m = 0; m < 4; ++m) rsv[ai][m] = rsqrtf(rsv[ai][m] * (1.0f / DM) + EPS); }
#pragma unroll
        for (int ai = 0; ai < 2; ++ai)
#pragma unroll
            for (int m = 0; m < 4; ++m) {
                const int row = row0 + ai * 128 + m * 16;
                f32x4 g0 = acc[ai][0][m][0], g1 = acc[ai][0][m][1], u0 = acc[ai][1][m][0], u1 = acc[ai][1][m][1];
                if (NORM) { const float rs = rsv[ai][m]; g0 = g0 * rs + sg0; g1 = g1 * rs + sg1; u0 = u0 * rs + su0; u1 = u1 * rs + su1; }
                u32x4 w;
                w.x = cvt_pk_bf16(silu_f(g0[0]) * u0[0], silu_f(g0[1]) * u0[1]); w.y = cvt_pk_bf16(silu_f(g0[2]) * u0[2], silu_f(g0[3]) * u0[3]);
                w.z = cvt_pk_bf16(silu_f(g1[0]) * u1[0], silu_f(g1[1]) * u1[1]); w.w = cvt_pk_bf16(silu_f(g1[2]) * u1[2], silu_f(g1[3]) * u1[3]);
                *(u32x4*)(hid + (size_t)row * DFF + col0) = w;
            }
    }
};
template <bool NORM, bool MID, bool HALFG>
struct EpiResid {
    static constexpr bool PERM = false, MIDSCALE = MID;
    static constexpr float scale = HALFG ? 0.5f : 1.0f;
    const float* srcP; const float* srcS; float* dst; const float* gate;
    bf16_t* hn; const float* gain; const float* sc; float* rss;
    const float* rsa; const float* rsb;
    __device__ __forceinline__ void midscale(f32x4 (&acc)[2][2][4][2], const Unit& u, int wr, int fr) const {
        const size_t row0 = (size_t)(u.pm * 256 + wr * 64 + fr);
        const float* pa = rsa + row0; const float* pb = rsb + row0;
#pragma unroll
        for (int ai = 0; ai < 2; ++ai)
#pragma unroll
            for (int m = 0; m < 4; ++m) {
                const float sa = __hip_atomic_load(pa + (ai * 128 + m * 16), __ATOMIC_RELAXED, __HIP_MEMORY_SCOPE_AGENT), sb = __hip_atomic_load(pb + (ai * 128 + m * 16), __ATOMIC_RELAXED, __HIP_MEMORY_SCOPE_AGENT);
                const float ra = rsqrtf(sa * (1.0f / 512) + EPS), rb = rsqrtf(sb * (1.0f / 512) + EPS), q = ra * __builtin_amdgcn_rcpf(rb);
#pragma unroll
                for (int bj = 0; bj < 2; ++bj)
#pragma unroll
                    for (int n = 0; n < 2; ++n) acc[ai][bj][m][n] *= q;
            }
    }
    __device__ __forceinline__ void operator()(AccRef acc, const Unit& u, int wr, int wc, int fr, int fq) const {
        const int row0 = u.pm * 256 + wr * 64 + fr, col0 = u.pn * 256 + wc * 32 + 4 * fq;
        const int b = batch_of_tile(u.pm);
        const float* src = (u.pm < 64 ? srcP : srcS - (size_t)MP * DM) + (size_t)row0 * DM + col0;
        float* dp = dst + (size_t)row0 * DM + col0;
        f32x4 gv[2][2], gs[2][2];
#pragma unroll
        for (int bj = 0; bj < 2; ++bj)
#pragma unroll
            for (int n = 0; n < 2; ++n) { const int c = col0 + bj * 128 + n * 16; gv[bj][n] = *(const f32x4*)(gate + (size_t)b * 9216 + c) * scale;
                if (NORM) gs[bj][n] = *(const f32x4*)(gain + c) * (*(const f32x4*)(sc + (size_t)b * 9216 + c) + 1.0f); }
        float rbv[2][4];
        if (MID) { const float* rp = rsb + row0;
#pragma unroll
            for (int ai = 0; ai < 2; ++ai)
#pragma unroll
                for (int m = 0; m < 4; ++m) rbv[ai][m] = rp[ai * 128 + m * 16];
#pragma unroll
            for (int ai = 0; ai < 2; ++ai)
#pragma unroll
                for (int m = 0; m < 4; ++m) rbv[ai][m] = rsqrtf(rbv[ai][m] * (1.0f / 512) + EPS); }
        constexpr int MB = NORM ? 2 : 4;
#pragma unroll
        for (int ai = 0; ai < 2; ++ai)
#pragma unroll
            for (int m0 = 0; m0 < 4; m0 += MB) {
                f32x4 bs[MB][2][2];
#pragma unroll
                for (int mm = 0; mm < MB; ++mm)
#pragma unroll
                    for (int bj = 0; bj < 2; ++bj)
#pragma unroll
                        for (int n = 0; n < 2; ++n) bs[mm][bj][n] = *(const f32x4*)(src + (size_t)(ai * 128 + (m0 + mm) * 16) * DM + bj * 128 + n * 16);
#pragma unroll
                for (int mm = 0; mm < MB; ++mm) {
                    const int m = m0 + mm;
                    float rb = 1.0f; if (MID) rb = rbv[ai][m];
                    float ss = 0.f;
#pragma unroll
                    for (int bj = 0; bj < 2; ++bj)
#pragma unroll
                        for (int n = 0; n < 2; ++n) {
                            f32x4 a = acc[ai][bj][m][n]; if (MID) a *= rb;
                            const f32x4 o = bs[mm][bj][n] + gv[bj][n] * a;
                            *(f32x4*)(dp + (size_t)(ai * 128 + m * 16) * DM + bj * 128 + n * 16) = o;
                            if (NORM) { ss += o[0] * o[0] + o[1] * o[1] + o[2] * o[2] + o[3] * o[3]; const f32x4 h = o * gs[bj][n]; u32x2 w; w.x = cvt_pk_bf16(h[0], h[1]); w.y = cvt_pk_bf16(h[2], h[3]);
                                *(u32x2*)(hn + (size_t)(row0 + ai * 128 + m * 16) * DM + col0 + bj * 128 + n * 16) = w; }
                        }
                    if (NORM) { ss += __shfl_xor(ss, 16); ss += __shfl_xor(ss, 32); if (fq == 0) unsafeAtomicAdd(rss + row0 + ai * 128 + m * 16, ss); }
                }
                asm volatile("" ::: "memory");
            }
    }
};
struct EpiMixIn {
    static constexpr bool PERM = true, MIDSCALE = false;
    bf16_t* ug; bf16_t* ugm; bf16_t* vg; const float* rss; const float* shw;
    __device__ __forceinline__ void operator()(AccRef acc, const Unit& u, int wr, int wc, int fr, int fq) const {
        const int row0 = u.pm * 256 + wr * 64 + fr, colt = wc * 32 + 8 * fq;
        const float* sp = shw + (size_t)batch_of_tile(u.pm) * NMIX + u.pn * 256 + colt;
        f32x4 sv[2][2];
#pragma unroll
        for (int bj = 0; bj < 2; ++bj)
#pragma unroll
            for (int n = 0; n < 2; ++n) sv[bj][n] = *(const f32x4*)(sp + bj * 128 + 4 * n);
        float rsv[2][4];
        { const float* rp = rss + row0;
#pragma unroll
            for (int ai = 0; ai < 2; ++ai)
#pragma unroll
                for (int m = 0; m < 4; ++m) rsv[ai][m] = rp[ai * 128 + m * 16];
#pragma unroll
            for (int ai = 0; ai < 2; ++ai)
#pragma unroll
                for (int m = 0; m < 4; ++m) rsv[ai][m] = rsqrtf(rsv[ai][m] * (1.0f / DM) + EPS); }
        if (u.pn < 2) {
#pragma unroll
            for (int ai = 0; ai < 2; ++ai)
#pragma unroll
                for (int m = 0; m < 4; ++m) { const int row = row0 + ai * 128 + m * 16; const float rs = rsv[ai][m];
#pragma unroll
                    for (int bj = 0; bj < 2; ++bj) { const int c = u.pn * 256 + bj * 128 + colt; const f32x4 v0 = acc[ai][bj][m][0] * rs + sv[bj][0], v1 = acc[ai][bj][m][1] * rs + sv[bj][1];
                        u32x4 w; w.x = cvt_pk_bf16(v0[0], v0[1]); w.y = cvt_pk_bf16(v0[2], v0[3]); w.z = cvt_pk_bf16(v1[0], v1[1]); w.w = cvt_pk_bf16(v1[2], v1[3]);
                        *(u32x4*)(ug + ((size_t)(c >> 4) * NCHK + (row >> 5)) * KS2 + (row & 31) * 16 + (c & 15)) = w; } }
        } else {
            bf16_t* o = (u.pn < 4 ? ugm : vg) + (u.pn & 1) * 256 + colt;
#pragma unroll
            for (int ai = 0; ai < 2; ++ai)
#pragma unroll
                for (int m = 0; m < 4; ++m) { const int row = row0 + ai * 128 + m * 16; const float rs = rsv[ai][m];
#pragma unroll
                    for (int bj = 0; bj < 2; ++bj) { const f32x4 v0 = acc[ai][bj][m][0] * rs + sv[bj][0], v1 = acc[ai][bj][m][1] * rs + sv[bj][1];
                        u32x4 w; w.x = cvt_pk_bf16(gelu_f(v0[0]), gelu_f(v0[1])); w.y = cvt_pk_bf16(gelu_f(v0[2]), gelu_f(v0[3])); w.z = cvt_pk_bf16(gelu_f(v1[0]), gelu_f(v1[1])); w.w = cvt_pk_bf16(gelu_f(v1[2]), gelu_f(v1[3]));
                        *(u32x4*)(o + (size_t)row * 512 + bj * 128) = w; } }
        }
    }
};
struct EpiS1 {
    static constexpr bool PERM = false, MIDSCALE = false;
    float* sloc;
    __device__ __forceinline__ void operator()(AccRef acc, const Unit& u, int wr, int wc, int fr, int fq) const {
        const int row0 = u.pm * 256 + wr * 64 + fr, col0 = wc * 32 + 4 * fq;
#pragma unroll
        for (int ai = 0; ai < 2; ++ai)
#pragma unroll
            for (int m = 0; m < 4; ++m) { float* rp = sloc + ((size_t)u.g * NCHK + row0 + ai * 128 + m * 16) * 256 + col0;
#pragma unroll
                for (int bj = 0; bj < 2; ++bj)
#pragma unroll
                    for (int n = 0; n < 2; ++n) *(f32x4*)(rp + bj * 128 + n * 16) = acc[ai][bj][m][n]; }
    }
};
struct EpiS2 {
    static constexpr bool PERM = true, MIDSCALE = false;
    bf16_t* y;
    __device__ __forceinline__ void operator()(AccRef acc, const Unit& u, int wr, int wc, int fr, int fq) const {
        const int row0 = u.pm * 256 + wr * 64 + fr, colt = u.pn * 256 + wc * 32 + 8 * fq;
#pragma unroll
        for (int ai = 0; ai < 2; ++ai)
#pragma unroll
            for (int m = 0; m < 4; ++m) { const int chunk = row0 + ai * 128 + m * 16;
#pragma unroll
                for (int bj = 0; bj < 2; ++bj) { const int c = colt + bj * 128; const f32x4 v0 = acc[ai][bj][m][0], v1 = acc[ai][bj][m][1];
                    u32x4 w; w.x = cvt_pk_bf16(gelu_f(v0[0]), gelu_f(v0[1])); w.y = cvt_pk_bf16(gelu_f(v0[2]), gelu_f(v0[3])); w.z = cvt_pk_bf16(gelu_f(v1[0]), gelu_f(v1[1])); w.w = cvt_pk_bf16(gelu_f(v1[2]), gelu_f(v1[3]));
                    *(u32x4*)(y + ((size_t)u.g * NCHK + chunk) * 512 + c) = w; } }
    }
};
struct EpiGlu {
    static constexpr bool PERM = true, MIDSCALE = false;
    const bf16_t* y; bf16_t* h; const float* gain; float* rssa;
    __device__ __forceinline__ void operator()(AccRef acc, const Unit& u, int wr, int wc, int fr, int fq) const {
        const int row0 = u.pm * 256 + wr * 64 + fr, col0 = u.pn * 256 + wc * 32 + 8 * fq;
        f32x4 gn[2][2];
#pragma unroll
        for (int bj = 0; bj < 2; ++bj)
#pragma unroll
            for (int n = 0; n < 2; ++n) gn[bj][n] = *(const f32x4*)(gain + col0 + bj * 128 + 4 * n);
        const bf16_t* yb = y + ((size_t)(col0 >> 4) * NCHK + (row0 >> 5)) * 512 + (row0 & 31) * 16 + (col0 & 15);
#pragma unroll
        for (int ai = 0; ai < 2; ++ai) {
            u32x4 yv[4][2];
#pragma unroll
            for (int m = 0; m < 4; ++m)
#pragma unroll
                for (int bj = 0; bj < 2; ++bj) yv[m][bj] = *(const u32x4*)(yb + (size_t)bj * 8 * NCHK * 512 + (ai * 4 + (m >> 1)) * 512 + (m & 1) * 256);
#pragma unroll
            for (int m = 0; m < 4; ++m) { const int row = row0 + ai * 128 + m * 16; float ss = 0.f;
#pragma unroll
                for (int bj = 0; bj < 2; ++bj) { const u32x4 q = yv[m][bj]; const f32x4 v0 = acc[ai][bj][m][0], v1 = acc[ai][bj][m][1];
                    f32x4 a, b; a[0] = bflo(q.x) * sigmoid_f(v0[0]); a[1] = bfhi(q.x) * sigmoid_f(v0[1]); a[2] = bflo(q.y) * sigmoid_f(v0[2]); a[3] = bfhi(q.y) * sigmoid_f(v0[3]);
                    b[0] = bflo(q.z) * sigmoid_f(v1[0]); b[1] = bfhi(q.z) * sigmoid_f(v1[1]); b[2] = bflo(q.w) * sigmoid_f(v1[2]); b[3] = bfhi(q.w) * sigmoid_f(v1[3]);
                    ss += a[0] * a[0] + a[1] * a[1] + a[2] * a[2] + a[3] * a[3] + b[0] * b[0] + b[1] * b[1] + b[2] * b[2] + b[3] * b[3];
                    a *= gn[bj][0]; b *= gn[bj][1];
                    u32x4 w; w.x = cvt_pk_bf16(a[0], a[1]); w.y = cvt_pk_bf16(a[2], a[3]); w.z = cvt_pk_bf16(b[0], b[1]); w.w = cvt_pk_bf16(b[2], b[3]);
                    *(u32x4*)(h + (size_t)row * DM + col0 + bj * 128) = w; }
                ss += __shfl_xor(ss, 16); ss += __shfl_xor(ss, 32); if (fq == 0) unsafeAtomicAdd(rssa + row, ss); }
            asm volatile("" ::: "memory");
        }
    }
};
struct EpiSpatial {
    static constexpr bool PERM = true, MIDSCALE = false;
    const bf16_t* ugm; const float* bsp; bf16_t* h; const float* gain; float* rssb;
    __device__ __forceinline__ void operator()(AccRef acc, const Unit& u, int wr, int wc, int fr, int fq) const {
        const int row0 = u.pm * 256 + wr * 64 + fr, col0 = u.pn * 256 + wc * 32 + 8 * fq, cc = wc * 32 + 8 * fq;
        const int q0 = row0 & 127;
        const bf16_t* up = ugm + ((size_t)(u.pn * 2) * 128 + q0) * 512 + cc;
        float bqv[2][4]; f32x4 gg[2][2];
#pragma unroll
        for (int ai = 0; ai < 2; ++ai) { gg[ai][0] = *(const f32x4*)(gain + (u.pm * 2 + ai) * 128 + cc); gg[ai][1] = *(const f32x4*)(gain + (u.pm * 2 + ai) * 128 + cc + 4);
#pragma unroll
            for (int m = 0; m < 4; ++m) bqv[ai][m] = bsp[(u.pm * 2 + ai) * 128 + q0 + m * 16]; }
#pragma unroll
        for (int ai = 0; ai < 2; ++ai) {
            const int hh = u.pm * 2 + ai;
            const f32x4 g0 = gg[ai][0], g1 = gg[ai][1];
            u32x4 uv[4][2];
#pragma unroll
            for (int m = 0; m < 4; ++m)
#pragma unroll
                for (int bj = 0; bj < 2; ++bj) uv[m][bj] = *(const u32x4*)(up + (size_t)(bj * 128 + m * 16) * 512 + hh * 128);
#pragma unroll
            for (int m = 0; m < 4; ++m) { const int q = q0 + m * 16; const float bq = bqv[ai][m];
#pragma unroll
                for (int bj = 0; bj < 2; ++bj) { const size_t tok = (size_t)(u.pn * 2 + bj) * 128 + q;
                    const u32x4 w0 = uv[m][bj]; const f32x4 v0 = acc[ai][bj][m][0], v1 = acc[ai][bj][m][1];
                    f32x4 a, b; a[0] = bflo(w0.x) * (v0[0] + bq); a[1] = bfhi(w0.x) * (v0[1] + bq); a[2] = bflo(w0.y) * (v0[2] + bq); a[3] = bfhi(w0.y) * (v0[3] + bq);
                    b[0] = bflo(w0.z) * (v1[0] + bq); b[1] = bfhi(w0.z) * (v1[1] + bq); b[2] = bflo(w0.w) * (v1[2] + bq); b[3] = bfhi(w0.w) * (v1[3] + bq);
                    float ss = a[0] * a[0] + a[1] * a[1] + a[2] * a[2] + a[3] * a[3] + b[0] * b[0] + b[1] * b[1] + b[2] * b[2] + b[3] * b[3];
                    a *= g0; b *= g1;
                    u32x4 w; w.x = cvt_pk_bf16(a[0], a[1]); w.y = cvt_pk_bf16(a[2], a[3]); w.z = cvt_pk_bf16(b[0], b[1]); w.w = cvt_pk_bf16(b[2], b[3]);
                    *(u32x4*)(h + tok * DM + 512 + hh * 128 + cc) = w;
                    ss += __shfl_xor(ss, 16); ss += __shfl_xor(ss, 32); if (fq == 0) unsafeAtomicAdd(rssb + tok, ss); } }
            asm volatile("" ::: "memory");
        }
    }
};

__device__ __forceinline__ void transpose_job(LAS unsigned char* lds, const float* src, int Kd, int Nd, bf16_t* dst, int mode) {
    LAS bf16_t* T = (LAS bf16_t*)lds;
    const int tid = threadIdx.x, nkt = Kd / 64, nnt = Nd / 64, ntile = nkt * nnt;
    for (int it = blockIdx.x; it < ntile; it += gridDim.x) {
        const int kt = it % nkt, ntl = it / nkt, k0 = kt * 64, n0 = ntl * 64;
        int n0d = n0;
        if (mode == 1) { const int j = n0 < DFF ? n0 : n0 - DFF; n0d = (j >> 7) * 256 + (j & 127) + (n0 < DFF ? 0 : 128); }
        __syncthreads();
#pragma unroll
        for (int i = 0; i < 8; ++i) { const int e = tid + i * 512, kl = e >> 6, nl = e & 63; T[nl * 66 + kl] = f2bf(src[(size_t)(k0 + kl) * Nd + n0 + nl]); }
        __syncthreads();
#pragma unroll
        for (int i = 0; i < 4; ++i) { const int e = tid + i * 512, nl = e >> 5, kp = e & 31; *(unsigned*)(dst + (size_t)(n0d + nl) * Kd + k0 + 2 * kp) = *(const LAS unsigned*)(T + nl * 66 + 2 * kp); }
    }
    __syncthreads();
}
__device__ __forceinline__ void s5_pow(float lre, float lim, double dt, int tau, double& er, double& ei) {
    const double m = exp((double)lre * dt * (double)tau), a = (double)lim * dt * (double)tau; double s, c; sincos(a, &s, &c); er = m * c; ei = m * s;
}
__device__ __forceinline__ void s5_f(float lre, float lim, double dt, double& fr, double& fi) {
    double ar, ai; s5_pow(lre, lim, dt, 1, ar, ai); const double nr = ar - 1.0, ni = ai, lr = (double)lre, li = (double)lim, den = lr * lr + li * li;
    fr = (nr * lr + ni * li) / den; fi = (ni * lr - nr * li) / den;
}

__device__ __forceinline__ void phase0(const P& p, LAS unsigned char* lds) {
    const int tid = threadIdx.x, G = gridDim.x, bid = blockIdx.x;
    unsigned char* ws = p.ws;
    {
        LAS float* S = (LAS float*)lds;
        float* MOD = (float*)(ws + WS_MOD);
        const float* wada = p.in[4]; const float* bada = p.in[5];
        for (int it = bid; it < 576; it += G) {
            const int cb = it % 36, kc = it / 36;
            __syncthreads();
            for (int e = tid; e < 1024; e += 512) { const int b = e >> 6, k = e & 63; const float* c = b < 8 ? p.in[2] + b * 1024 : p.in[3] + (b - 8) * 1024; const float v = c[kc * 64 + k]; S[e] = silu_f(v); }
            __syncthreads();
            const int col = cb * 256 + (tid & 255), kh = tid >> 8;
            float acc[16];
#pragma unroll
            for (int b = 0; b < 16; ++b) acc[b] = 0.f;
#pragma unroll 8
            for (int kk = 0; kk < 32; ++kk) { const int k = kh * 32 + kk; const float w = wada[(size_t)(kc * 64 + k) * 9216 + col];
#pragma unroll
                for (int b = 0; b < 16; ++b) acc[b] += S[b * 64 + k] * w; }
            if (kc == 0 && kh == 0) { const float bb = bada[col];
#pragma unroll
                for (int b = 0; b < 16; ++b) acc[b] += bb; }
#pragma unroll
            for (int b = 0; b < 16; ++b) unsafeAtomicAdd(MOD + b * 9216 + col, acc[b]);
        }
        __syncthreads();
    }
    transpose_job(lds, p.in[7], DM, NIN, (bf16_t*)(ws + WS_WIN1), 1);
    transpose_job(lds, p.in[35], DM, NIN, (bf16_t*)(ws + WS_WIN2), 1);
    transpose_job(lds, p.in[8], DFF, DM, (bf16_t*)(ws + WS_WOUT1), 0);
    transpose_job(lds, p.in[36], DFF, DM, (bf16_t*)(ws + WS_WOUT2), 0);
    transpose_job(lds, p.in[10], DM, NMIX, (bf16_t*)(ws + WS_WMIXIN), 0);
    transpose_job(lds, p.in[26], 512, 512, (bf16_t*)(ws + WS_WGLU), 0);
    transpose_job(lds, p.in[33], DM, DM, (bf16_t*)(ws + WS_WMIXOUT), 0);
    {
        bf16_t* wbd = (bf16_t*)(ws + WS_WBD); const float* wsp = p.in[29];
        for (int i = bid * 512 + tid; i < 512 * 64; i += G * 512) {
            const int kg = i & 63, row = i >> 6, h = row >> 7, q = row & 127, col0 = kg * 8, hp = col0 >> 7, k0 = col0 & 127;
            u32x4 w = (u32x4){0u, 0u, 0u, 0u};
            if (h == hp) { const float* s = wsp + ((size_t)h * 128 + q) * 128 + k0; const f32x4 a = *(const f32x4*)s, b = *(const f32x4*)(s + 4);
                w.x = cvt_pk_bf16(a[0], a[1]); w.y = cvt_pk_bf16(a[2], a[3]); w.z = cvt_pk_bf16(b[0], b[1]); w.w = cvt_pk_bf16(b[2], b[3]); }
            *(u32x4*)(wbd + (size_t)row * 512 + col0) = w;
        }
    }
    {
        LAS float* EBr = (LAS float*)lds; LAS float* EBi = EBr + 1024;
        float* klag = (float*)(ws + WS_KLAG);
        for (int it = bid; it < NGRP * 63; it += G) {
            const int g = it / 63, l = it % 63;
            float accv = 0.f;
            for (int dir = 0; dir < 2; ++dir) {
                if ((dir == 0 && l > 31) || (dir == 1 && l < 31)) continue;
                const int tau = dir == 0 ? 31 - l : l - 31; const int o = dir * 7;
                const float* lre = p.in[11 + o]; const float* lim = p.in[12 + o]; const float* lst = p.in[13 + o];
                const float* bre = p.in[14 + o]; const float* bim = p.in[15 + o]; const float* cre = p.in[16 + o]; const float* cim = p.in[17 + o];
                const double dt = exp((double)lst[g]);
                __syncthreads();
                for (int idx = tid; idx < 1024; idx += 512) { const int pp = idx >> 4, hp = idx & 15; const float a = lre[g * 64 + pp], b = lim[g * 64 + pp];
                    double er, ei, fr, fi; s5_pow(a, b, dt, tau, er, ei); s5_f(a, b, dt, fr, fi);
                    const double gr = er * fr - ei * fi, gi = er * fi + ei * fr; const double br = bre[(g * 64 + pp) * 16 + hp], bi = bim[(g * 64 + pp) * 16 + hp];
                    EBr[idx] = (float)(gr * br - gi * bi); EBi[idx] = (float)(gr * bi + gi * br); }
                __syncthreads();
                if (tid < 256) { const int h = tid >> 4, hp = tid & 15; const float* cr = cre + (g * 16 + h) * 64; const float* ci = cim + (g * 16 + h) * 64; float s = 0.f;
                    for (int pp = 0; pp < 64; ++pp) s += cr[pp] * EBr[pp * 16 + hp] - ci[pp] * EBi[pp * 16 + hp];
                    accv += s; }
            }
            if (tid < 256) { const int h = tid >> 4, hp = tid & 15; if (l == 31 && h == hp) accv += p.in[25][g * 16 + h]; klag[((size_t)g * 63 + l) * 256 + tid] = accv; }
        }
        __syncthreads();
    }
    {
        bf16_t* w1s = (bf16_t*)(ws + WS_W1S); bf16_t* w2s = (bf16_t*)(ws + WS_W2S);
        for (int it = bid; it < NGRP * 2 * 32; it += G) {
            const int t = it & 31, dir = (it >> 5) & 1, g = it >> 6; const int o = dir * 7;
            const int pp = tid & 63, hh = tid >> 6;
            const float a = p.in[11 + o][g * 64 + pp], b = p.in[12 + o][g * 64 + pp]; const double dt = exp((double)p.in[13 + o][g]);
            double e1r, e1i, e2r, e2i, fr, fi;
            s5_pow(a, b, dt, dir == 0 ? 31 - t : t, e1r, e1i); s5_pow(a, b, dt, dir == 0 ? t + 1 : 32 - t, e2r, e2i); s5_f(a, b, dt, fr, fi);
            const double gr = e1r * fr - e1i * fi, gi = e1r * fi + e1i * fr;
#pragma unroll
            for (int j = 0; j < 2; ++j) { const int h = 2 * hh + j;
                const double br = p.in[14 + o][(g * 64 + pp) * 16 + h], bi = p.in[15 + o][(g * 64 + pp) * 16 + h];
                w1s[((size_t)g * 256 + dir * 128 + pp) * 512 + t * 16 + h] = f2bf((float)(gr * br - gi * bi));
                w1s[((size_t)g * 256 + dir * 128 + 64 + pp) * 512 + t * 16 + h] = f2bf((float)(gr * bi + gi * br));
                const double cr = p.in[16 + o][(g * 16 + h) * 64 + pp], ci = p.in[17 + o][(g * 16 + h) * 64 + pp];
                w2s[((size_t)g * 512 + t * 16 + h) * KS2 + 512 + dir * 128 + pp] = f2bf((float)(cr * e2r - ci * e2i));
                w2s[((size_t)g * 512 + t * 16 + h) * KS2 + 512 + dir * 128 + 64 + pp] = f2bf((float)(-(cr * e2i + ci * e2r))); }
        }
    }
}

__device__ __forceinline__ void pass_modnorm_in(const P& p, const float* gain, int shidx) {
    const int lane = threadIdx.x & 63, wave = threadIdx.x >> 6;
    const float* MOD = (const float*)(p.ws + WS_MOD); bf16_t* H = (bf16_t*)(p.ws + WS_H);
    const int stride = gridDim.x * 8;
    for (int row = blockIdx.x * 8 + wave; row < MT; row += 2 * stride) {
        const int row2 = row + stride;
        const bool has2 = row2 < MT;
        const float* s0 = row < MP ? p.in[0] + (size_t)row * DM : p.in[1] + (size_t)(row - MP) * DM;
        const int r2 = has2 ? row2 : row;
        const float* s1 = r2 < MP ? p.in[0] + (size_t)r2 * DM : p.in[1] + (size_t)(r2 - MP) * DM;
        f32x4 v[4], w[4]; float ss = 0.f, tt = 0.f;
#pragma unroll
        for (int i = 0; i < 4; ++i) { v[i] = *(const f32x4*)(s0 + i * 256 + lane * 4); w[i] = *(const f32x4*)(s1 + i * 256 + lane * 4); }
#pragma unroll
        for (int i = 0; i < 4; ++i) { ss += v[i][0] * v[i][0] + v[i][1] * v[i][1] + v[i][2] * v[i][2] + v[i][3] * v[i][3]; tt += w[i][0] * w[i][0] + w[i][1] * w[i][1] + w[i][2] * w[i][2] + w[i][3] * w[i][3]; }
        ss = wave_sum(ss); tt = wave_sum(tt);
        const float rs0 = rsqrtf(ss * (1.0f / DM) + EPS), rs1 = rsqrtf(tt * (1.0f / DM) + EPS);
        const float* sh0 = MOD + (size_t)batch_of_row(row) * 9216 + shidx * 1024; const float* sh1 = MOD + (size_t)batch_of_row(r2) * 9216 + shidx * 1024;
#pragma unroll
        for (int i = 0; i < 4; ++i) { const int c = i * 256 + lane * 4; const f32x4 g4 = *(const f32x4*)(gain + c);
            { const f32x4 s4 = *(const f32x4*)(sh0 + 1024 + c), h4 = *(const f32x4*)(sh0 + c); const f32x4 o = v[i] * rs0 * g4 * (s4 + 1.0f) + h4; u32x2 q; q.x = cvt_pk_bf16(o[0], o[1]); q.y = cvt_pk_bf16(o[2], o[3]); *(u32x2*)(H + (size_t)row * DM + c) = q; }
            if (has2) { const f32x4 s4 = *(const f32x4*)(sh1 + 1024 + c), h4 = *(const f32x4*)(sh1 + c); const f32x4 o = w[i] * rs1 * g4 * (s4 + 1.0f) + h4; u32x2 q; q.x = cvt_pk_bf16(o[0], o[1]); q.y = cvt_pk_bf16(o[2], o[3]); *(u32x2*)(H + (size_t)row2 * DM + c) = q; } }
    }
}
__device__ __forceinline__ void pass_shw(const P& p, LAS unsigned char* lds, const bf16_t* Wt, int N, int shidx, float* out) {
    const int tid = threadIdx.x, lane = tid & 63, wave = tid >> 6;
    LAS float* S = (LAS float*)lds;
    const float* MOD = (const float*)(p.ws + WS_MOD);
    __syncthreads();
    for (int e = tid; e < 16 * 256; e += 512) { const int b = e >> 8, k4 = e & 255; *(LAS f32x4*)(S + b * 1024 + k4 * 4) = *(const f32x4*)(MOD + (size_t)b * 9216 + shidx * 1024 + k4 * 4); }
    __syncthreads();
    for (int n = blockIdx.x * 8 + wave; n < N; n += gridDim.x * 8) {
        float w[16];
#pragma unroll
        for (int j = 0; j < 4; ++j) { const u32x2 q = *(const u32x2*)(Wt + (size_t)n * DM + j * 256 + lane * 4); w[j * 4] = bflo(q.x); w[j * 4 + 1] = bfhi(q.x); w[j * 4 + 2] = bflo(q.y); w[j * 4 + 3] = bfhi(q.y); }
        float mine = 0.f;
#pragma unroll 1
        for (int b = 0; b < 16; ++b) { float a = 0.f;
#pragma unroll
            for (int j = 0; j < 4; ++j) { const f32x4 s4 = *(const LAS f32x4*)(S + b * 1024 + j * 256 + lane * 4); a += w[j * 4] * s4[0] + w[j * 4 + 1] * s4[1] + w[j * 4 + 2] * s4[2] + w[j * 4 + 3] * s4[3]; }
            a = wave_sum(a); if (lane == b) mine = a; }
        if (lane < 16) out[(size_t)lane * N + n] = mine;
    }
    __syncthreads();
}
__device__ __forceinline__ void pass_final(const P& p) {
    const int lane = threadIdx.x & 63, wave = threadIdx.x >> 6; const float* gain = p.in[37];
    for (int row = blockIdx.x * 8 + wave; row < MT; row += gridDim.x * 8) {
        float* src = p.out + (size_t)row * DM; f32x4 v[4]; float ss = 0.f;
#pragma unroll
        for (int i = 0; i < 4; ++i) { v[i] = *(const f32x4*)(src + i * 256 + lane * 4); ss += v[i][0] * v[i][0] + v[i][1] * v[i][1] + v[i][2] * v[i][2] + v[i][3] * v[i][3]; }
        ss = wave_sum(ss); const float rstd = rsqrtf(ss * (1.0f / DM) + EPS);
#pragma unroll
        for (int i = 0; i < 4; ++i) { const int c = i * 256 + lane * 4; *(f32x4*)(src + c) = v[i] * rstd * *(const f32x4*)(gain + c); }
    }
}
__device__ __forceinline__ void fill_kmat(const P& p) {
    const float* klag = (const float*)(p.ws + WS_KLAG); bf16_t* w2s = (bf16_t*)(p.ws + WS_W2S);
    for (int i = blockIdx.x * 512 + threadIdx.x; i < NGRP * 512 * 64; i += gridDim.x * 512) {
        const int kg = i & 63, n = (i >> 6) & 511, g = i >> 15, t = n >> 4, h = n & 15, s = kg >> 1, hp0 = (kg & 1) * 8, l = s - t + 31;
        const float* src = klag + ((size_t)g * 63 + l) * 256 + h * 16 + hp0; const f32x4 a = *(const f32x4*)src, b = *(const f32x4*)(src + 4);
        u32x4 w; w.x = cvt_pk_bf16(a[0], a[1]); w.y = cvt_pk_bf16(a[2], a[3]); w.z = cvt_pk_bf16(b[0], b[1]); w.w = cvt_pk_bf16(b[2], b[3]);
        *(u32x4*)(w2s + ((size_t)g * 512 + n) * KS2 + s * 16 + hp0) = w;
    }
}
__device__ __forceinline__ void pass_ln_transpose(const P& p, LAS unsigned char* lds) {
    const int tid = threadIdx.x, lane = tid & 63, wave = tid >> 6;
    LAS float* ST = (LAS float*)lds;
    LAS bf16_t* T = (LAS bf16_t*)(lds + 1024);
    const bf16_t* vg = (const bf16_t*)(p.ws + WS_VG); bf16_t* vt = (bf16_t*)(p.ws + WS_VT);
    const float* lg = p.in[27]; const float* lb = p.in[28];
    for (int bn = blockIdx.x; bn < MT / 128; bn += gridDim.x) {
        __syncthreads();
        for (int tt = 0; tt < 16; ++tt) { const int k = wave * 16 + tt; const u32x4 a = *(const u32x4*)(vg + ((size_t)bn * 128 + k) * 512 + lane * 8);
            const float x[8] = {bflo(a.x), bfhi(a.x), bflo(a.y), bfhi(a.y), bflo(a.z), bfhi(a.z), bflo(a.w), bfhi(a.w)};
            float s = 0.f, q = 0.f;
#pragma unroll
            for (int j = 0; j < 8; ++j) { s += x[j]; q += x[j] * x[j]; }
            s = wave_sum(s); q = wave_sum(q); const float mu = s * (1.0f / 512), var = fmaxf(q * (1.0f / 512) - mu * mu, 0.f);
            if (lane == 0) { ST[k * 2] = mu; ST[k * 2 + 1] = rsqrtf(var + EPS); } }
        __syncthreads();
        for (int h = 0; h < 4; ++h) {
#pragma unroll
            for (int i = 0; i < 4; ++i) { const int idx = tid + i * 512, k = idx >> 4, c0 = (idx & 15) * 8;
                const u32x4 a = *(const u32x4*)(vg + ((size_t)bn * 128 + k) * 512 + h * 128 + c0); const float mu = ST[k * 2], rs = ST[k * 2 + 1];
                const float x[8] = {bflo(a.x), bfhi(a.x), bflo(a.y), bfhi(a.y), bflo(a.z), bfhi(a.z), bflo(a.w), bfhi(a.w)};
                const f32x4 g0 = *(const f32x4*)(lg + h * 128 + c0), g1 = *(const f32x4*)(lg + h * 128 + c0 + 4), b0 = *(const f32x4*)(lb + h * 128 + c0), b1 = *(const f32x4*)(lb + h * 128 + c0 + 4);
#pragma unroll
                for (int j = 0; j < 4; ++j) { T[(c0 + j) * 136 + k] = f2bf((x[j] - mu) * rs * g0[j] + b0[j]); T[(c0 + 4 + j) * 136 + k] = f2bf((x[4 + j] - mu) * rs * g1[j] + b1[j]); } }
            __syncthreads();
#pragma unroll
            for (int i = 0; i < 4; ++i) { const int idx = tid + i * 512, c = idx >> 4, kg = idx & 15;
                *(u32x4*)(vt + (((size_t)bn * 128 + c) * 4 + h) * 128 + kg * 8) = *(const LAS u32x4*)(T + c * 136 + kg * 8); }
            __syncthreads();
        }
    }
}
__device__ __forceinline__ void pass_chunk_scan(const P& p) {
    const float* sloc = (const float*)(p.ws + WS_SLOC); bf16_t* ug = (bf16_t*)(p.ws + WS_UG);
    for (int T = blockIdx.x * 512 + threadIdx.x; T < 16 * NGRP * 128; T += gridDim.x * 512) {
        const int j = T & 127, dir = j >> 6, pp = j & 63, g = (T >> 7) & 31, b = T >> 12;
        const int cb = b < 8 ? b * 64 : 512 + (b - 8) * 256, nc = b < 8 ? 64 : 256; const int o = dir * 7;
        const double dt = exp((double)p.in[13 + o][g]); double er, ei; s5_pow(p.in[11 + o][g * 64 + pp], p.in[12 + o][g * 64 + pp], dt, TCH, er, ei);
        const float ar = (float)er, ai = (float)ei;
        const float* lp = sloc + ((size_t)g * NCHK + cb) * 256 + dir * 128 + pp;
        bf16_t* up = ug + ((size_t)g * NCHK + cb) * KS2 + 512 + dir * 128 + pp;
        float sr = 0.f, si = 0.f;
        for (int c0 = 0; c0 < nc; c0 += 8) {
            float lr[8], li[8];
#pragma unroll
            for (int q = 0; q < 8; ++q) { const int c = dir == 0 ? c0 + q : nc - 1 - (c0 + q); lr[q] = lp[(size_t)c * 256]; li[q] = lp[(size_t)c * 256 + 64]; }
#pragma unroll
            for (int q = 0; q < 8; ++q) { const int c = dir == 0 ? c0 + q : nc - 1 - (c0 + q);
                up[(size_t)c * KS2] = f2bf(sr); up[(size_t)c * KS2 + 64] = f2bf(si);
                const float nr = ar * sr - ai * si + lr[q], ni = ar * si + ai * sr + li[q]; sr = nr; si = ni; }
        }
    }
}


#define XB_TMO      128
#define XB_XCNT(j)  (256  + 64 * (j))
#define XB_XSUB(j)  (1280 + 64 * (j))
#define XB_XGEN(j)  (2304 + 64 * (j))
#define XB_TOP      3328
#define XB_TOPGEN   3392
#define XCD_BAR_WORDS 3456
#define XB_SPIN_CAP (1u << 18)
__device__ __forceinline__ unsigned xb_ld(unsigned* p)              { return __hip_atomic_load(p, __ATOMIC_RELAXED, __HIP_MEMORY_SCOPE_AGENT); }
__device__ __forceinline__ unsigned xb_add(unsigned* p, unsigned v) { return __hip_atomic_fetch_add(p, v, __ATOMIC_RELAXED, __HIP_MEMORY_SCOPE_AGENT); }
__device__ __forceinline__ unsigned xb_xcc_id() { return (unsigned)__builtin_amdgcn_s_getreg((3 << 11) | 20) & 0xFu; }
#define XB_SPIN(cond, bar) do { unsigned _sp = 0; while (cond) { __builtin_amdgcn_s_sleep(1); \
    if ((++_sp & 255u) == 0u) { if (xb_ld(&(bar)[XB_TMO])) break; if (_sp > XB_SPIN_CAP) { atomicAdd(&(bar)[XB_TMO], 1u); break; } } } } while (0)
struct XcdBarrier { unsigned* bar; unsigned x; volatile LAS unsigned* st; };
__device__ __forceinline__ XcdBarrier xcd_barrier_post(unsigned* bar, volatile LAS unsigned* st) {
    XcdBarrier b; b.bar = bar; b.x = xb_xcc_id(); b.st = st;
    if (threadIdx.x == 0) (void)xb_add(&bar[XB_XCNT(b.x)], 1u);
    return b;
}
__device__ __forceinline__ void xcd_barrier_complete(unsigned* bar, unsigned x, unsigned& nloc, unsigned& nx) {
    const unsigned G = gridDim.x * gridDim.y * gridDim.z;
    unsigned sum, cnt, mine, sp = 0u;
    for (;;) {
        sum = 0u; cnt = 0u; mine = 0u;
#pragma unroll
        for (unsigned j = 0; j < 16; ++j) { const unsigned c = xb_ld(&bar[XB_XCNT(j)]); sum += c; cnt += (c > 0u) ? 1u : 0u; mine = (j == x) ? c : mine; }
        if (sum == G) break;
        __builtin_amdgcn_s_sleep(1);
        if ((++sp & 255u) == 0u) { if (xb_ld(&bar[XB_TMO])) break; if (sp > XB_SPIN_CAP) { atomicAdd(&bar[XB_TMO], 1u); break; } }
    }
    nloc = mine > 0u ? mine : 1u; nx = cnt > 0u ? cnt : 1u;
}
__device__ __forceinline__ void xcd_barrier(const XcdBarrier& b) {
    asm volatile("s_waitcnt vmcnt(0)" ::: "memory");
    __syncthreads();
    if (threadIdx.x == 0) {
        unsigned* bar = b.bar;
        __builtin_amdgcn_s_waitcnt(0);
        unsigned nloc = b.st[0], nx = b.st[1];
        if (nloc == 0u) { xcd_barrier_complete(bar, b.x, nloc, nx); b.st[0] = nloc; b.st[1] = nx; }
        const unsigned old = xb_add(&bar[XB_XSUB(b.x)], 1u);
        const unsigned gen = old / nloc;
        if (old + 1u == (gen + 1u) * nloc) {
            __builtin_amdgcn_fence(__ATOMIC_RELEASE, "agent");
            asm volatile("s_waitcnt vmcnt(0)" ::: "memory");
            const unsigned og = xb_add(&bar[XB_TOP], 1u);
            const unsigned tg = og / nx;
            if (og + 1u == (tg + 1u) * nx) xb_add(&bar[XB_TOPGEN], 1u);
            else XB_SPIN(xb_ld(&bar[XB_TOPGEN]) == tg, bar);
            __builtin_amdgcn_fence(__ATOMIC_ACQUIRE, "agent");
            xb_add(&bar[XB_XGEN(b.x)], 1u);
            asm volatile("s_waitcnt vmcnt(0)" ::: "memory");
        } else {
            XB_SPIN(xb_ld(&bar[XB_XGEN(b.x)]) == gen, bar);
            __builtin_amdgcn_fence(__ATOMIC_ACQUIRE, "agent");
            asm volatile("s_waitcnt vmcnt(0)" ::: "memory");
        }
    }
    __syncthreads();
}

__global__ void __launch_bounds__(512, 2) mega(P p) {
    extern __shared__ __attribute__((aligned(16))) unsigned char lds_raw[];
    LAS unsigned char* lds = (LAS unsigned char*)lds_raw;
    cg::grid_group grid = cg::this_grid();
    if (threadIdx.x < 4) ((volatile LAS unsigned*)(lds + LDS_STAGE))[threadIdx.x] = 0u;
    __syncthreads();
    { XcdBarrier xb0 = xcd_barrier_post((unsigned*)(p.ws + WS_BAR), (volatile LAS unsigned*)(lds + LDS_STAGE)); (void)xb0; }
    const int lo = p.ph_lo, hi = p.ph_hi, G = gridDim.x, bid = blockIdx.x;
#define B_MOD ((const float*)(p.ws + WS_MOD))
#define B_H ((bf16_t*)(p.ws + WS_H))
#define B_HID ((bf16_t*)(p.ws + WS_HID))
#define B_UG ((bf16_t*)(p.ws + WS_UG))
#define B_UGM ((bf16_t*)(p.ws + WS_UGM))
#define B_VG ((bf16_t*)(p.ws + WS_VG))
#define B_VT ((bf16_t*)(p.ws + WS_VT))
#define B_SLOC ((float*)(p.ws + WS_SLOC))
#define B_Y ((bf16_t*)(p.ws + WS_SLOC))
#define B_H2 ((bf16_t*)(p.ws + WS_H2))
#define B_RSS1 ((float*)(p.ws + WS_RSS1))
#define B_RSS2 ((float*)(p.ws + WS_RSS2))
#define B_RSSA ((float*)(p.ws + WS_RSSA))
#define B_RSSB ((float*)(p.ws + WS_RSSB))
#ifndef PHMASK
#define PHMASK 0xFFFF
#endif
#define IN(k) (((PHMASK >> (k)) & 1) && lo <= (k) && (k) < hi)
#define SYNC(k) do { if (IN(k) && IN((k) + 1)) { if ((k) == 0) grid.sync(); else { unsigned char* w_ = p.ws; asm volatile("" : "+s"(w_)); XcdBarrier xb_; xb_.bar = (unsigned*)(w_ + WS_BAR); xb_.x = xb_xcc_id(); xb_.st = (volatile LAS unsigned*)(lds + LDS_STAGE); xcd_barrier(xb_); } } } while (0)
    if (IN(0)) phase0(p, lds);
    SYNC(0);
    if (IN(1)) { pass_modnorm_in(p, p.in[6], 0); fill_kmat(p);
        pass_shw(p, lds, (const bf16_t*)(p.ws + WS_WMIXIN), NMIX, 3, (float*)(p.ws + WS_SHW2)); pass_shw(p, lds, (const bf16_t*)(p.ws + WS_WIN2), NIN, 6, (float*)(p.ws + WS_SHW3)); }
    SYNC(1);
    if (IN(2)) { pg8::Gemm g{B_H, (const bf16_t*)(p.ws + WS_WIN1), DM, DM, DM, 0, 0, 0}; pg8::Order S; S.init(MT / 256, NIN / 256, 1, G, bid); EpiSwiglu<false> E{B_HID, nullptr, nullptr}; pg8::gemm_phase(lds, g, S, E); }
    SYNC(2);
    if (IN(3)) { pg8::Gemm g{B_HID, (const bf16_t*)(p.ws + WS_WOUT1), DFF, DFF, DFF, 0, 0, 0}; pg8::Order S; S.init(MT / 256, DM / 256, 1, G, bid);
        EpiResid<true, false, true> E{p.in[0], p.in[1], p.out, B_MOD + 2 * 1024, B_H, p.in[9], B_MOD + 4 * 1024, B_RSS1, nullptr, nullptr}; pg8::gemm_phase(lds, g, S, E); }
    SYNC(3);
    if (IN(4)) { pg8::Gemm g{B_H, (const bf16_t*)(p.ws + WS_WMIXIN), DM, DM, DM, 0, 0, 0}; pg8::Order S; S.init(MT / 256, NMIX / 256, 1, G, bid); EpiMixIn E{B_UG, B_UGM, B_VG, B_RSS1, (const float*)(p.ws + WS_SHW2)}; pg8::gemm_phase(lds, g, S, E); }
    SYNC(4);
    if (IN(5)) { pass_ln_transpose(p, lds);
        pg8::Gemm g{B_UG, (const bf16_t*)(p.ws + WS_W1S), KS2, 512, 512, (size_t)NCHK * KS2, (size_t)256 * 512, 0}; pg8::Order S; S.init(NCHK / 256, 1, NGRP, G, bid); EpiS1 E{B_SLOC}; pg8::gemm_phase(lds, g, S, E); }
    SYNC(5);
    if (IN(6)) { pass_chunk_scan(p);
        pg8::Gemm g{(const bf16_t*)(p.ws + WS_WBD), B_VT, 512, 512, 512, 0, 0, 0}; pg8::Order S; S.init(2, MT / 256, 1, G, bid); EpiSpatial E{B_UGM, p.in[30], B_H, p.in[32], B_RSSB}; pg8::gemm_phase(lds, g, S, E); }
    SYNC(6);
    if (IN(7)) { pg8::Gemm g{B_UG, (const bf16_t*)(p.ws + WS_W2S), KS2, KS2, KS2, (size_t)NCHK * KS2, (size_t)512 * KS2, 0}; pg8::Order S; S.init(NCHK / 256, 2, NGRP, G, bid); EpiS2 E{B_Y}; pg8::gemm_phase(lds, g, S, E); }
    SYNC(7);
    if (IN(8)) { pg8::Gemm g{B_Y, (const bf16_t*)(p.ws + WS_WGLU), 512, 512, 512, 0, 0, 1}; pg8::Order S; S.init(MT / 256, 2, 1, G, bid); EpiGlu E{B_Y, B_H, p.in[31], B_RSSA}; pg8::gemm_phase(lds, g, S, E); }
    SYNC(8);
    if (IN(9)) { pg8::Gemm g{B_H, (const bf16_t*)(p.ws + WS_WMIXOUT), DM, DM, DM, 0, 0, 0}; pg8::Order S; S.init(MT / 256, DM / 256, 1, G, bid);
        EpiResid<true, true, false> E{p.out, p.out + (size_t)MP * DM, p.out, B_MOD + 5 * 1024, B_H2, p.in[34], B_MOD + 7 * 1024, B_RSS2, B_RSSA, B_RSSB}; pg8::gemm_phase(lds, g, S, E); }
    SYNC(9);
    if (IN(10)) { pg8::Gemm g{B_H2, (const bf16_t*)(p.ws + WS_WIN2), DM, DM, DM, 0, 0, 0}; pg8::Order S; S.init(MT / 256, NIN / 256, 1, G, bid); EpiSwiglu<true> E{B_HID, B_RSS2, (const float*)(p.ws + WS_SHW3)}; pg8::gemm_phase(lds, g, S, E); }
    SYNC(10);
    if (IN(11)) { pg8::Gemm g{B_HID, (const bf16_t*)(p.ws + WS_WOUT2), DFF, DFF, DFF, 0, 0, 0}; pg8::Order S; S.init(MT / 256, DM / 256, 1, G, bid);
        EpiResid<false, false, true> E{p.out, p.out + (size_t)MP * DM, p.out, B_MOD + 8 * 1024, nullptr, nullptr, nullptr, nullptr, nullptr, nullptr}; pg8::gemm_phase(lds, g, S, E); }
    SYNC(11);
    if (IN(12)) pass_final(p);
#undef IN
#undef SYNC
}

extern "C" void kernel_launch(void* const* d_in, const int* in_sizes, int n_in, void* d_out, int out_size, void* d_ws, size_t ws_size, hipStream_t stream) {
    static int grid = 0;
    if (grid == 0) {
        if (n_in != 38 || out_size != MT * DM || ws_size < WS_END) { fprintf(stderr, "kernel_launch: unexpected shapes: n_in %d out %d ws %zu (need %zu)\n", n_in, out_size, ws_size, (size_t)WS_END); grid = -1; return; }
        int dev = 0, cus = 0, per_cu = 0;
        (void)hipGetDevice(&dev); (void)hipDeviceGetAttribute(&cus, hipDeviceAttributeMultiprocessorCount, dev);
        if (hipFuncSetAttribute((const void*)mega, hipFuncAttributeMaxDynamicSharedMemorySize, LDS_BYTES) != hipSuccess) { fprintf(stderr, "kernel_launch: hipFuncSetAttribute failed\n"); grid = -1; return; }
        (void)hipOccupancyMaxActiveBlocksPerMultiprocessor(&per_cu, (const void*)mega, 512, LDS_BYTES);
        if (per_cu < 1) per_cu = 1;
        grid = cus * 1;
        (void)hipGetLastError();
        fprintf(stderr, "kernel_launch: cus %d per_cu %d grid %d ws need %zu have %zu\n", cus, per_cu, grid, (size_t)WS_END, ws_size);
    }
    if (grid < 0) return;
    (void)hipMemsetAsync((char*)d_ws + WS_MOD, 0, ZERO_BYTES, stream);
    P p{};
    for (int i = 0; i < 38; ++i) p.in[i] = (const float*)d_in[i];
    p.out = (float*)d_out; p.ws = (unsigned char*)d_ws;
#if N_LAUNCH_MODE == 0
    p.ph_lo = 0; p.ph_hi = NPHASE;
    void* args[] = {&p};
    hipError_t e = hipLaunchCooperativeKernel((const void*)mega, dim3(grid), dim3(512), args, LDS_BYTES, stream);
    if (e != hipSuccess) fprintf(stderr, "cooperative launch failed: %s (grid %d)\n", hipGetErrorString(e), grid);
#else
    for (int k = 0; k < NPHASE; ++k) { p.ph_lo = k; p.ph_hi = k + 1; hipLaunchKernelGGL(mega, dim3(grid), dim3(512), LDS_BYTES, stream, p); }
#endif
}
```

```cpp
#include <hip/hip_runtime.h>
#include <hip/hip_cooperative_groups.h>
#include <cstdio>
namespace cg = cooperative_groups;

#define LAS __attribute__((address_space(3)))
typedef unsigned short bf16_t;
typedef short bf16x8 __attribute__((ext_vector_type(8)));
typedef float f32x4 __attribute__((ext_vector_type(4)));
typedef unsigned u32x4 __attribute__((ext_vector_type(4)));
typedef unsigned u32x2 __attribute__((ext_vector_type(2)));

#ifndef N_LAUNCH_MODE
#define N_LAUNCH_MODE 0
#endif

constexpr int MT = 81920;
constexpr int MP = 16384;
constexpr int DM = 1024, DFF = 2816, NIN = 5632, NMIX = 1536;
constexpr int NGRP = 32, TCH = 32, NCHK = MT / TCH  , KS2 = 768;
constexpr float EPS = 1e-6f;
constexpr int NPHASE = 12;

constexpr size_t al256(size_t x) { return (x + 255) & ~(size_t)255; }
constexpr size_t WS_MOD = 0;
constexpr size_t MOD_BYTES = 16 * 9216 * 4;
constexpr size_t WS_RSS1 = WS_MOD + MOD_BYTES;
constexpr size_t WS_RSS2 = WS_RSS1 + (size_t)MT * 4;
constexpr size_t WS_RSSA = WS_RSS2 + (size_t)MT * 4;
constexpr size_t WS_RSSB = WS_RSSA + (size_t)MT * 4;
constexpr size_t WS_RSS3 = WS_RSSB + (size_t)MT * 4;
constexpr size_t WS_PCNT = WS_RSS3 + (size_t)MT * 4;
constexpr size_t WS_BAR = WS_PCNT + (size_t)640 * 256;
constexpr size_t ZERO_BYTES = WS_BAR + 3456 * 4;
constexpr size_t WS_SHW2 = ZERO_BYTES;
constexpr size_t WS_SHW3 = WS_SHW2 + 16 * 1536 * 4;
constexpr size_t WS_WIN1 = al256(WS_SHW3 + 16 * 5632 * 4);
constexpr size_t WS_WIN2 = WS_WIN1 + (size_t)NIN * DM * 2;
constexpr size_t WS_WOUT1 = WS_WIN2 + (size_t)NIN * DM * 2;
constexpr size_t WS_WOUT2 = WS_WOUT1 + (size_t)DM * DFF * 2;
constexpr size_t WS_WMIXIN = WS_WOUT2 + (size_t)DM * DFF * 2;
constexpr size_t WS_WGLU = WS_WMIXIN + (size_t)NMIX * DM * 2;
constexpr size_t WS_WMIXOUT = WS_WGLU + 512 * 512 * 2;
constexpr size_t WS_WBD = WS_WMIXOUT + (size_t)DM * DM * 2;
constexpr size_t WS_KLAG = WS_WBD + 512 * 512 * 2;
constexpr size_t WS_W1S = WS_KLAG + (size_t)NGRP * 63 * 256 * 4;
constexpr size_t WS_W2S = WS_W1S + (size_t)NGRP * 256 * 512 * 2;
constexpr size_t WS_H = WS_W2S + (size_t)NGRP * 512 * KS2 * 2;
constexpr size_t WS_H2 = WS_H + (size_t)MT * DM * 2;
constexpr size_t WS_R = WS_H2 + (size_t)MT * DM * 2;
constexpr size_t WS_HID = WS_R;
constexpr size_t WS_UG = WS_R;
constexpr size_t WS_UGM = WS_UG + (size_t)NGRP * NCHK * KS2 * 2;
constexpr size_t WS_VG = WS_UGM + (size_t)MT * 512 * 2;
constexpr size_t WS_VT = WS_VG + (size_t)MT * 512 * 2;
constexpr size_t WS_SLOC = WS_VT + (size_t)MT * 512 * 2;
constexpr size_t WS_END = WS_R + (size_t)MT * DFF * 2;
static_assert(WS_SLOC + (size_t)NGRP * NCHK * 256 * 4 <= WS_END, "mixer buffers must fit the HID region");

constexpr int LDS_STAGE = 131072;
constexpr int LDS_BYTES = LDS_STAGE + 16;

struct P { const float* in[38]; float* out; unsigned char* ws; int ph_lo, ph_hi; };

__device__ __forceinline__ unsigned cvt_pk_bf16(float lo, float hi) { unsigned r; asm volatile("v_cvt_pk_bf16_f32 %0, %1, %2" : "=v"(r) : "v"(lo), "v"(hi)); return r; }
__device__ __forceinline__ bf16_t f2bf(float f) { return (bf16_t)(cvt_pk_bf16(f, 0.f) & 0xffffu); }
__device__ __forceinline__ float bflo(unsigned w) { return __uint_as_float(w << 16); }
__device__ __forceinline__ float bfhi(unsigned w) { return __uint_as_float(w & 0xffff0000u); }
__device__ __forceinline__ float wave_sum(float v) {
#pragma unroll
    for (int o = 32; o; o >>= 1) v += __shfl_xor(v, o);
    return v;
}
__device__ __forceinline__ float sigmoid_f(float a) { return __builtin_amdgcn_rcpf(1.f + __expf(-a)); }
__device__ __forceinline__ float gelu_f(float x) { return x * sigmoid_f(1.5957691216f * (x + 0.044715f * x * x * x)); }
__device__ __forceinline__ float silu_f(float x) { return x * sigmoid_f(x); }
__device__ __forceinline__ int batch_of_row(int row) { return row < MP ? (row >> 11) : 8 + ((row - MP) >> 13); }
__device__ __forceinline__ int batch_of_tile(int pm) { return pm < 64 ? (pm >> 3) : 8 + ((pm - 64) >> 5); }

namespace pg8 {
constexpr int BM = 256, BK = 64, HALF = 128, HTB = HALF * BK * 2, NXCD = 8, WGM = 8;
__device__ __forceinline__ int lds_byte(int r, int c) { const int st = (r >> 4) * 2 + (c >> 5), rr = r & 15, cc = c & 31, ob = rr * 64 + cc * 2; return st * 1024 + (ob ^ (((ob >> 9) & 1) << 5)); }
__device__ __forceinline__ void stage_rc(int b, int& R, int& C) { const int st = b / 1024, sb = b % 1024, swz = sb ^ (((sb >> 9) & 1) << 5); R = (st >> 1) * 16 + swz / 64; C = (st & 1) * 32 + (swz % 64) / 2; }
__device__ __forceinline__ int perm32(int rho) { const int n = rho >> 4, i = rho & 15; return 8 * (i >> 2) + 4 * n + (i & 3); }

__device__ __forceinline__ const char* uni_ptr(const char* q) { const unsigned long long v = (unsigned long long)q; const unsigned lo = __builtin_amdgcn_readfirstlane((unsigned)v), hi = __builtin_amdgcn_readfirstlane((unsigned)(v >> 32)); return (const char*)(((unsigned long long)hi << 32) | lo); }
struct Unit { int pm, pn, g; };
struct Gemm { const bf16_t* A; const bf16_t* Bt; int lda, ldb, K; size_t gsA, gsB; int amode; };
struct Order {
    int nM, nN, ntot, G, c;
    __device__ void init(int nM_, int nN_, int nG_, int G_, int c_) { nM = nM_; nN = nN_; ntot = nM_ * nN_ * nG_; G = G_; c = c_; }
    __device__ bool next(int i, Unit& u) const {
        const long L = (long)i * G + c; if (L >= ntot) return false;
        int wgid = (int)L; { const int q = ntot / NXCD, r = ntot % NXCD, xcd = wgid % NXCD, off = wgid / NXCD; wgid = (xcd < r ? xcd * (q + 1) : r * (q + 1) + (xcd - r) * q) + off; }
        const int per = nM * nN; u.g = wgid / per; const int w = wgid - u.g * per;
        const int nig = WGM * nN, gid = w / nig, fm = gid * WGM, gsz = (nM - fm) < WGM ? (nM - fm) : WGM;
        u.pm = fm + ((w % nig) % gsz); u.pn = (w % nig) / gsz; return true;
    }
};

template <class Epi>
__device__ __forceinline__ void gemm_phase(LAS unsigned char* lds, const Gemm g, const Order& S, const Epi& E) {
    int tid_ = threadIdx.x; asm volatile("" : "+v"(tid_));
    const int tid = tid_, wid = __builtin_amdgcn_readfirstlane(tid >> 6), lane = tid & 63, wr = wid >> 2, wc = wid & 3, fr = lane & 15, fq = lane >> 4;
    const int K = g.K, nt = K / BK;
    unsigned voffA[2], voffB[2];
#pragma unroll
    for (int i = 0; i < 2; ++i) { int R, C; stage_rc(tid * 16 + i * 8192, R, C); const int Rb = Epi::PERM ? ((R & ~31) + perm32(R & 31)) : R;
        voffA[i] = g.amode ? (unsigned)((C >> 4) * (2560 * 512) + (R >> 5) * 512 + (R & 31) * 16 + (C & 15)) * 2u : (unsigned)(R * g.lda + C) * 2u; voffB[i] = (unsigned)(Rb * g.ldb + C) * 2u; }
    const size_t kstep = (size_t)(BK * 2), kstepA = g.amode ? (size_t)4 * 2560 * 512 * 2 : kstep;
    const size_t hstepA = g.amode ? (size_t)4 * 512 * 2 : (size_t)HALF * g.lda * 2, hstepB = (size_t)HALF * g.ldb * 2;
    const size_t tstepA = 2 * hstepA, tstepB = 2 * hstepB;
    const unsigned ldsw = (unsigned)wid * 1024u;
    const int aoff = lds_byte(wr * 64 + fr, fq * 8), boff = lds_byte(wc * 32 + fr, fq * 8);
#define PG8_SA(b, h) (((b) * 2 + (h)) * HTB)
#define PG8_SB(b, h) ((4 + (b) * 2 + (h)) * HTB)
#define PG8_STAGE(bufoff, gbase, voff) do { _Pragma("unroll") for (int _i = 0; _i < 2; ++_i) \
        __builtin_amdgcn_global_load_lds((const unsigned*)((const char*)(gbase) + (voff)[_i]), (LAS unsigned*)(lds + (bufoff) + ldsw + _i * 8192), 16, 0, 0); } while (0)
#define PG8_LDA(dst, b, h) do { _Pragma("unroll") for (int m = 0; m < 4; ++m) _Pragma("unroll") for (int k = 0; k < 2; ++k) dst[m][k] = *(const LAS bf16x8*)(lds + PG8_SA(b, h) + aoff + m * 2048 + k * 1024); } while (0)
#define PG8_LDB(dst, b, h) do { _Pragma("unroll") for (int n = 0; n < 2; ++n) _Pragma("unroll") for (int k = 0; k < 2; ++k) dst[n][k] = *(const LAS bf16x8*)(lds + PG8_SB(b, h) + boff + n * 2048 + k * 1024); } while (0)
#define PG8_MMA(ai, bj, At, Bt) do { __builtin_amdgcn_s_setprio(1); _Pragma("unroll") for (int m = 0; m < 4; ++m) _Pragma("unroll") for (int n = 0; n < 2; ++n) _Pragma("unroll") for (int k = 0; k < 2; ++k) \
        acc[ai][bj][m][n] = __builtin_amdgcn_mfma_f32_16x16x32_bf16(Bt[n][k], At[m][k], acc[ai][bj][m][n], 0, 0, 0); __builtin_amdgcn_s_setprio(0); } while (0)
#define PG8_WAIT_V(n) asm volatile("s_waitcnt vmcnt(" #n ")" ::: "memory")
#define PG8_WAIT_L(n) asm volatile("s_waitcnt lgkmcnt(" #n ")" ::: "memory")
#define PG8_BAR __builtin_amdgcn_s_barrier()
#define PG8_SCHED __builtin_amdgcn_sched_barrier(0)
#define PG8_BASEA(u) uni_ptr((const char*)g.A + ((size_t)(u).g * g.gsA) * 2 + (size_t)(u).pm * tstepA)
#define PG8_BASEB(u) uni_ptr((const char*)g.Bt + ((size_t)(u).g * g.gsB) * 2 + (size_t)(u).pn * tstepB)
    Unit cur, nxt; int ui = 0;
    if (!S.next(0, cur)) return;
    f32x4 acc[2][2][4][2];
#pragma unroll
    for (int a = 0; a < 2; ++a)
#pragma unroll
        for (int b = 0; b < 2; ++b)
#pragma unroll
            for (int m = 0; m < 4; ++m)
#pragma unroll
                for (int n = 0; n < 2; ++n) acc[a][b][m][n] = (f32x4){0.f, 0.f, 0.f, 0.f};
    bf16x8 At[4][2], B0[2][2], B1[2][2];
    const char* cA = PG8_BASEA(cur); const char* cB = PG8_BASEB(cur);
    PG8_STAGE(PG8_SB(0, 0), cB, voffB); PG8_STAGE(PG8_SA(0, 0), cA, voffA); PG8_STAGE(PG8_SB(0, 1), cB + hstepB, voffB); PG8_STAGE(PG8_SA(0, 1), cA + hstepA, voffA);
    if (wr == 1) PG8_BAR;
    PG8_WAIT_V(4); PG8_BAR;
    PG8_STAGE(PG8_SB(1, 0), cB + kstep, voffB); PG8_STAGE(PG8_SA(1, 0), cA + kstepA, voffA); PG8_STAGE(PG8_SB(1, 1), cB + hstepB + kstep, voffB);
    PG8_WAIT_V(6); PG8_BAR;
    for (;;) {
        const bool has_next = S.next(ui + 1, nxt);
        const char* nA = has_next ? PG8_BASEA(nxt) : cA; const char* nB = has_next ? PG8_BASEB(nxt) : cB;
        for (int t = 0; t < nt; t += 2) {
            const bool last = (t == nt - 2);
            const char* a1 = cA + (size_t)(t + 1) * kstepA;
            const char* a2 = last ? nA : cA + (size_t)(t + 2) * kstepA; const char* b2 = last ? nB : cB + (size_t)(t + 2) * kstep;
            const char* a3 = a2 + kstepA; const char* b3 = b2 + kstep;
            if constexpr (Epi::MIDSCALE) { if (t == 8) E.midscale(acc, cur, wr, fr); }
            PG8_LDB(B0, 0, 0); PG8_SCHED; PG8_LDA(At, 0, 0); PG8_STAGE(PG8_SA(1, 1), a1 + hstepA, voffA);
            PG8_WAIT_L(8); PG8_BAR; PG8_WAIT_L(0); PG8_MMA(0, 0, At, B0); PG8_BAR; PG8_SCHED;
            PG8_LDB(B1, 0, 1); PG8_STAGE(PG8_SB(0, 0), b2, voffB);
            PG8_BAR; PG8_WAIT_L(0); PG8_MMA(0, 1, At, B1); PG8_BAR;
            PG8_LDA(At, 0, 1); PG8_STAGE(PG8_SA(0, 0), a2, voffA);
            PG8_BAR; PG8_WAIT_L(0); PG8_MMA(1, 0, At, B0); PG8_BAR; PG8_SCHED;
            PG8_STAGE(PG8_SB(0, 1), b2 + hstepB, voffB);
            PG8_WAIT_V(6); PG8_BAR; PG8_MMA(1, 1, At, B1); PG8_BAR;
            PG8_LDB(B0, 1, 0); PG8_SCHED; PG8_LDA(At, 1, 0); PG8_STAGE(PG8_SA(0, 1), a2 + hstepA, voffA);
            PG8_WAIT_L(8); PG8_BAR; PG8_WAIT_L(0); PG8_MMA(0, 0, At, B0); PG8_BAR; PG8_SCHED;
            PG8_LDB(B1, 1, 1); PG8_STAGE(PG8_SB(1, 0), b3, voffB);
            PG8_BAR; PG8_WAIT_L(0); PG8_MMA(0, 1, At, B1); PG8_BAR;
            PG8_LDA(At, 1, 1); PG8_STAGE(PG8_SA(1, 0), a3, voffA);
            PG8_BAR; PG8_WAIT_L(0); PG8_MMA(1, 0, At, B0); PG8_BAR; PG8_SCHED;
            PG8_STAGE(PG8_SB(1, 1), b3 + hstepB, voffB);
            PG8_WAIT_V(6); PG8_BAR; PG8_MMA(1, 1, At, B1); PG8_BAR;
        }
        E(acc, cur, wr, wc, fr, fq);
        if (!has_next) break;
#pragma unroll
        for (int a = 0; a < 2; ++a)
#pragma unroll
            for (int b = 0; b < 2; ++b)
#pragma unroll
                for (int m = 0; m < 4; ++m)
#pragma unroll
                    for (int n = 0; n < 2; ++n) acc[a][b][m][n] = (f32x4){0.f, 0.f, 0.f, 0.f};
        cur = nxt; cA = nA; cB = nB; ++ui;
    }
    PG8_WAIT_V(0);
    if (wr == 0) PG8_BAR;
    PG8_BAR;
#undef PG8_SA
#undef PG8_SB
#undef PG8_STAGE
#undef PG8_LDA
#undef PG8_LDB
#undef PG8_MMA
#undef PG8_WAIT_V
#undef PG8_WAIT_L
#undef PG8_BAR
#undef PG8_SCHED
#undef PG8_BASEA
#undef PG8_BASEB
}
}
using pg8::Unit;
typedef const f32x4 (&AccRef)[2][2][4][2];

template <bool NORM>
struct EpiSwiglu {
    static constexpr bool PERM = true, MIDSCALE = false;
    bf16_t* hid; const float* rss; const float* shw;
    __device__ __forceinline__ void operator()(AccRef acc, const Unit& u, int wr, int wc, int fr, int fq) const {
        const int row0 = u.pm * 256 + wr * 64 + fr, col0 = u.pn * 128 + wc * 32 + 8 * fq;
        f32x4 sg0, sg1, su0, su1;
        float rsv[2][4];
        if (NORM) { const float* sp = shw + (size_t)batch_of_tile(u.pm) * NIN + u.pn * 256 + wc * 32 + 8 * fq; sg0 = *(const f32x4*)sp; sg1 = *(const f32x4*)(sp + 4); su0 = *(const f32x4*)(sp + 128); su1 = *(const f32x4*)(sp + 132);
            const float* rp = rss + row0;
#pragma unroll
            for (int ai = 0; ai < 2; ++ai)
#pragma unroll
                for (int m = 0; m < 4; ++m) rsv[ai][m] = rp[ai * 128 + m * 16];
#pragma unroll
            for (int ai = 0; ai < 2; ++ai)
#pragma unroll
                for (int m = 0; m < 4; ++m) rsv[ai][m] = rsqrtf(rsv[ai][m] * (1.0f / DM) + EPS); }
#pragma unroll
        for (int ai = 0; ai < 2; ++ai)
#pragma unroll
            for (int m = 0; m < 4; ++m) {
                const int row = row0 + ai * 128 + m * 16;
                f32x4 g0 = acc[ai][0][m][0], g1 = acc[ai][0][m][1], u0 = acc[ai][1][m][0], u1 = acc[ai][1][m][1];
                if (NORM) { const float rs = rsv[ai][m]; g0 = g0 * rs + sg0; g1 = g1 * rs + sg1; u0 = u0 * rs + su0; u1 = u1 * rs + su1; }
                u32x4 w;
                w.x = cvt_pk_bf16(silu_f(g0[0]) * u0[0], silu_f(g0[1]) * u0[1]); w.y = cvt_pk_bf16(silu_f(g0[2]) * u0[2], silu_f(g0[3]) * u0[3]);
                w.z = cvt_pk_bf16(silu_f(g1[0]) * u1[0], silu_f(g1[1]) * u1[1]); w.w = cvt_pk_bf16(silu_f(g1[2]) * u1[2], silu_f(g1[3]) * u1[3]);
                *(u32x4*)(hid + (size_t)row * DFF + col0) = w;
            }
    }
};
template <bool NORM, bool MID, bool HALFG>
struct EpiResid {
    static constexpr bool PERM = false, MIDSCALE = MID;
    static constexpr float scale = HALFG ? 0.5f : 1.0f;
    const float* srcP; const float* srcS; float* dst; const float* gate;
    bf16_t* hn; const float* gain; const float* sc; float* rss;
    const float* rsa; const float* rsb;
    __device__ __forceinline__ void midscale(f32x4 (&acc)[2][2][4][2], const Unit& u, int wr, int fr) const {
        const size_t row0 = (size_t)(u.pm * 256 + wr * 64 + fr);
        const float* pa = rsa + row0; const float* pb = rsb + row0;
#pragma unroll
        for (int ai = 0; ai < 2; ++ai)
#pragma unroll
            for (int m = 0; m < 4; ++m) {
                const float sa = __hip_atomic_load(pa + (ai * 128 + m * 16), __ATOMIC_RELAXED, __HIP_MEMORY_SCOPE_AGENT), sb = __hip_atomic_load(pb + (ai * 128 + m * 16), __ATOMIC_RELAXED, __HIP_MEMORY_SCOPE_AGENT);
                const float ra = rsqrtf(sa * (1.0f / 512) + EPS), rb = rsqrtf(sb * (1.0f / 512) + EPS), q = ra * __builtin_amdgcn_rcpf(rb);
#pragma unroll
                for (int bj = 0; bj < 2; ++bj)
#pragma unroll
                    for (int n = 0; n < 2; ++n) acc[ai][bj][m][n] *= q;
            }
    }
    __device__ __forceinline__ void operator()(f32x4 (&acc)[2][2][4][2], const Unit& u, int wr, int wc, int fr, int fq) const {
        const int row0 = u.pm * 256 + wr * 64 + fr, col0 = u.pn * 256 + wc * 32 + 4 * fq;
        const int b = batch_of_tile(u.pm);
        const float* src = (u.pm < 64 ? srcP : srcS - (size_t)MP * DM) + (size_t)row0 * DM + col0;
        float* dp = dst + (size_t)row0 * DM + col0;
        {
            f32x4 gv[2][2];
#pragma unroll
            for (int bj = 0; bj < 2; ++bj)
#pragma unroll
                for (int n = 0; n < 2; ++n) gv[bj][n] = *(const f32x4*)(gate + (size_t)b * 9216 + col0 + bj * 128 + n * 16) * scale;
            float rbv[2][4];
            if (MID) { const float* rp = rsb + row0;
#pragma unroll
                for (int ai = 0; ai < 2; ++ai)
#pragma unroll
                    for (int m = 0; m < 4; ++m) rbv[ai][m] = rp[ai * 128 + m * 16];
#pragma unroll
                for (int ai = 0; ai < 2; ++ai)
#pragma unroll
                    for (int m = 0; m < 4; ++m) rbv[ai][m] = rsqrtf(rbv[ai][m] * (1.0f / 512) + EPS); }
#pragma unroll
            for (int ai = 0; ai < 2; ++ai)
#pragma unroll
                for (int m = 0; m < 4; ++m) {
#pragma unroll
                    for (int bj = 0; bj < 2; ++bj)
#pragma unroll
                        for (int n = 0; n < 2; ++n) { if (MID) acc[ai][bj][m][n] *= gv[bj][n] * rbv[ai][m]; else acc[ai][bj][m][n] *= gv[bj][n]; }
                    asm volatile("" : "+v"(acc[ai][0][m][0]), "+v"(acc[ai][0][m][1]), "+v"(acc[ai][1][m][0]), "+v"(acc[ai][1][m][1]));
                }
        }
        f32x4 gs[2][2];
        if (NORM) {
#pragma unroll
            for (int bj = 0; bj < 2; ++bj)
#pragma unroll
                for (int n = 0; n < 2; ++n) { const int c = col0 + bj * 128 + n * 16; gs[bj][n] = *(const f32x4*)(gain + c) * (*(const f32x4*)(sc + (size_t)b * 9216 + c) + 1.0f); }
        }
        constexpr int MB = NORM ? 2 : 4;
#pragma unroll
        for (int ai = 0; ai < 2; ++ai)
#pragma unroll
            for (int m0 = 0; m0 < 4; m0 += MB) {
                f32x4 bs[MB][2][2];
#pragma unroll
                for (int mm = 0; mm < MB; ++mm)
#pragma unroll
                    for (int bj = 0; bj < 2; ++bj)
#pragma unroll
                        for (int n = 0; n < 2; ++n) bs[mm][bj][n] = *(const f32x4*)(src + (size_t)(ai * 128 + (m0 + mm) * 16) * DM + bj * 128 + n * 16);
#pragma unroll
                for (int mm = 0; mm < MB; ++mm) {
                    const int m = m0 + mm;
                    float ss = 0.f;
#pragma unroll
                    for (int bj = 0; bj < 2; ++bj)
#pragma unroll
                        for (int n = 0; n < 2; ++n) {
                            const f32x4 o = bs[mm][bj][n] + acc[ai][bj][m][n];
                            *(f32x4*)(dp + (size_t)(ai * 128 + m * 16) * DM + bj * 128 + n * 16) = o;
                            if (NORM) { ss += o[0] * o[0] + o[1] * o[1] + o[2] * o[2] + o[3] * o[3]; const f32x4 h = o * gs[bj][n]; u32x2 w; w.x = cvt_pk_bf16(h[0], h[1]); w.y = cvt_pk_bf16(h[2], h[3]);
                                *(u32x2*)(hn + (size_t)(row0 + ai * 128 + m * 16) * DM + col0 + bj * 128 + n * 16) = w; }
                        }
                    if (NORM) { ss += __shfl_xor(ss, 16); ss += __shfl_xor(ss, 32); if (fq == 0) unsafeAtomicAdd(rss + row0 + ai * 128 + m * 16, ss); }
                }
                asm volatile("" ::: "memory");
            }
    }
};
struct EpiResidFinal {
    static constexpr bool PERM = false, MIDSCALE = false;
    const float* src; float* dst; const float* gate; const float* gfin; float* rss3; unsigned* pcnt;
    __device__ __forceinline__ void operator()(f32x4 (&acc)[2][2][4][2], const Unit& u, int wr, int wc, int fr, int fq) const {
        const int row0 = u.pm * 256 + wr * 64 + fr, col0 = u.pn * 256 + wc * 32 + 4 * fq;
        const int b = batch_of_tile(u.pm);
        float* xp = dst + (size_t)row0 * DM + col0;
        {
            f32x4 gv[2][2];
#pragma unroll
            for (int bj = 0; bj < 2; ++bj)
#pragma unroll
                for (int n = 0; n < 2; ++n) gv[bj][n] = *(const f32x4*)(gate + (size_t)b * 9216 + col0 + bj * 128 + n * 16) * 0.5f;
#pragma unroll
            for (int ai = 0; ai < 2; ++ai) {
                f32x4 bs[4][2][2];
#pragma unroll
                for (int mm = 0; mm < 4; ++mm)
#pragma unroll
                    for (int bj = 0; bj < 2; ++bj)
#pragma unroll
                        for (int n = 0; n < 2; ++n) bs[mm][bj][n] = *(const f32x4*)(xp + (size_t)(ai * 128 + mm * 16) * DM + bj * 128 + n * 16);
#pragma unroll
                for (int mm = 0; mm < 4; ++mm) {
#pragma unroll
                    for (int bj = 0; bj < 2; ++bj)
#pragma unroll
                        for (int n = 0; n < 2; ++n) acc[ai][bj][mm][n] = bs[mm][bj][n] + gv[bj][n] * acc[ai][bj][mm][n];
                    asm volatile("" : "+v"(acc[ai][0][mm][0]), "+v"(acc[ai][0][mm][1]), "+v"(acc[ai][1][mm][0]), "+v"(acc[ai][1][mm][1]));
                }
                asm volatile("" ::: "memory");
            }
        }
        float* rp = rss3 + row0;
        float keep = 0.f;
#pragma unroll
        for (int ai = 0; ai < 2; ++ai)
#pragma unroll
            for (int m = 0; m < 4; ++m) { float ss = 0.f;
#pragma unroll
                for (int bj = 0; bj < 2; ++bj)
#pragma unroll
                    for (int n = 0; n < 2; ++n) { const f32x4 o = acc[ai][bj][m][n]; ss += o[0] * o[0] + o[1] * o[1] + o[2] * o[2] + o[3] * o[3]; }
                ss += __shfl_xor(ss, 16); ss += __shfl_xor(ss, 32);
                if (fq == 0) keep += __hip_atomic_fetch_add(rp + (ai * 128 + m * 16), ss, __ATOMIC_RELAXED, __HIP_MEMORY_SCOPE_AGENT); }
        asm volatile("s_waitcnt vmcnt(0)" :: "v"(keep) : "memory");
        unsigned* cp = pcnt + (size_t)(u.pm * 2 + wr) * 64;
        if ((threadIdx.x & 63) == 0) __hip_atomic_fetch_add(cp, 1u, __ATOMIC_RELAXED, __HIP_MEMORY_SCOPE_AGENT);
        { unsigned spins = 0;
          while ((unsigned)__builtin_amdgcn_readfirstlane(__hip_atomic_load(cp, __ATOMIC_RELAXED, __HIP_MEMORY_SCOPE_AGENT)) < 16u) { __builtin_amdgcn_s_sleep(1); if (++spins > (1u << 17)) break; } }
        asm volatile("" ::: "memory");
        float rsv[2][4];
#pragma unroll
        for (int ai = 0; ai < 2; ++ai)
#pragma unroll
            for (int m = 0; m < 4; ++m) rsv[ai][m] = __hip_atomic_load(rp + (ai * 128 + m * 16), __ATOMIC_RELAXED, __HIP_MEMORY_SCOPE_AGENT);
        f32x4 gf[2][2];
#pragma unroll
        for (int bj = 0; bj < 2; ++bj)
#pragma unroll
            for (int n = 0; n < 2; ++n) gf[bj][n] = *(const f32x4*)(gfin + col0 + bj * 128 + n * 16);
#pragma unroll
        for (int ai = 0; ai < 2; ++ai)
#pragma unroll
            for (int m = 0; m < 4; ++m) { const float rs = rsqrtf(rsv[ai][m] * (1.0f / DM) + EPS);
#pragma unroll
                for (int bj = 0; bj < 2; ++bj)
#pragma unroll
                    for (int n = 0; n < 2; ++n) *(f32x4*)(xp + (size_t)(ai * 128 + m * 16) * DM + bj * 128 + n * 16) = acc[ai][bj][m][n] * rs * gf[bj][n]; }
    }
};
struct EpiMixIn {
    static constexpr bool PERM = true, MIDSCALE = false;
    bf16_t* ug; bf16_t* ugm; bf16_t* vg; const float* rss; const float* shw;
    __device__ __forceinline__ void operator()(AccRef acc, const Unit& u, int wr, int wc, int fr, int fq) const {
        const int row0 = u.pm * 256 + wr * 64 + fr, colt = wc * 32 + 8 * fq;
        const float* sp = shw + (size_t)batch_of_tile(u.pm) * NMIX + u.pn * 256 + colt;
        f32x4 sv[2][2];
#pragma unroll
        for (int bj = 0; bj < 2; ++bj)
#pragma unroll
            for (int n = 0; n < 2; ++n) sv[bj][n] = *(const f32x4*)(sp + bj * 128 + 4 * n);
        float rsv[2][4];
        { const float* rp = rss + row0;
#pragma unroll
            for (int ai = 0; ai < 2; ++ai)
#pragma unroll
                for (int m = 0; m < 4; ++m) rsv[ai][m] = rp[ai * 128 + m * 16];
#pragma unroll
            for (int ai = 0; ai < 2; ++ai)
#pragma unroll
                for (int m = 0; m < 4; ++m) rsv[ai][m] = rsqrtf(rsv[ai][m] * (1.0f / DM) + EPS); }
        if (u.pn < 2) {
#pragma unroll
            for (int ai = 0; ai < 2; ++ai)
#pragma unroll
                for (int m = 0; m < 4; ++m) { const int row = row0 + ai * 128 + m * 16; const float rs = rsv[ai][m];
#pragma unroll
                    for (int bj = 0; bj < 2; ++bj) { const int c = u.pn * 256 + bj * 128 + colt; const f32x4 v0 = acc[ai][bj][m][0] * rs + sv[bj][0], v1 = acc[ai][bj][m][1] * rs + sv[bj][1];
                        u32x4 w; w.x = cvt_pk_bf16(v0[0], v0[1]); w.y = cvt_pk_bf16(v0[2], v0[3]); w.z = cvt_pk_bf16(v1[0], v1[1]); w.w = cvt_pk_bf16(v1[2], v1[3]);
                        *(u32x4*)(ug + ((size_t)(c >> 4) * NCHK + (row >> 5)) * KS2 + (row & 31) * 16 + (c & 15)) = w; } }
        } else {
            bf16_t* o = (u.pn < 4 ? ugm : vg) + (u.pn & 1) * 256 + colt;
#pragma unroll
            for (int ai = 0; ai < 2; ++ai)
#pragma unroll
                for (int m = 0; m < 4; ++m) { const int row = row0 + ai * 128 + m * 16; const float rs = rsv[ai][m];
#pragma unroll
                    for (int bj = 0; bj < 2; ++bj) { const f32x4 v0 = acc[ai][bj][m][0] * rs + sv[bj][0], v1 = acc[ai][bj][m][1] * rs + sv[bj][1];
                        u32x4 w; w.x = cvt_pk_bf16(gelu_f(v0[0]), gelu_f(v0[1])); w.y = cvt_pk_bf16(gelu_f(v0[2]), gelu_f(v0[3])); w.z = cvt_pk_bf16(gelu_f(v1[0]), gelu_f(v1[1])); w.w = cvt_pk_bf16(gelu_f(v1[2]), gelu_f(v1[3]));
                        *(u32x4*)(o + (size_t)row * 512 + bj * 128) = w; } }
        }
    }
};
struct EpiS1 {
    static constexpr bool PERM = false, MIDSCALE = false;
    float* sloc;
    __device__ __forceinline__ void operator()(AccRef acc, const Unit& u, int wr, int wc, int fr, int fq) const {
        const int row0 = u.pm * 256 + wr * 64 + fr, col0 = wc * 32 + 4 * fq;
#pragma unroll
        for (int ai = 0; ai < 2; ++ai)
#pragma unroll
            for (int m = 0; m < 4; ++m) { float* rp = sloc + ((size_t)u.g * NCHK + row0 + ai * 128 + m * 16) * 256 + col0;
#pragma unroll
                for (int bj = 0; bj < 2; ++bj)
#pragma unroll
                    for (int n = 0; n < 2; ++n) *(f32x4*)(rp + bj * 128 + n * 16) = acc[ai][bj][m][n]; }
    }
};
struct EpiS2 {
    static constexpr bool PERM = true, MIDSCALE = false;
    bf16_t* y;
    __device__ __forceinline__ void operator()(AccRef acc, const Unit& u, int wr, int wc, int fr, int fq) const {
        const int row0 = u.pm * 256 + wr * 64 + fr, colt = u.pn * 256 + wc * 32 + 8 * fq;
#pragma unroll
        for (int ai = 0; ai < 2; ++ai)
#pragma unroll
            for (int m = 0; m < 4; ++m) { const int chunk = row0 + ai * 128 + m * 16;
#pragma unroll
                for (int bj = 0; bj < 2; ++bj) { const int c = colt + bj * 128; const f32x4 v0 = acc[ai][bj][m][0], v1 = acc[ai][bj][m][1];
                    u32x4 w; w.x = cvt_pk_bf16(gelu_f(v0[0]), gelu_f(v0[1])); w.y = cvt_pk_bf16(gelu_f(v0[2]), gelu_f(v0[3])); w.z = cvt_pk_bf16(gelu_f(v1[0]), gelu_f(v1[1])); w.w = cvt_pk_bf16(gelu_f(v1[2]), gelu_f(v1[3]));
                    *(u32x4*)(y + ((size_t)u.g * NCHK + chunk) * 512 + c) = w; } }
    }
};
struct EpiGlu {
    static constexpr bool PERM = true, MIDSCALE = false;
    const bf16_t* y; bf16_t* h; const float* gain; float* rssa;
    __device__ __forceinline__ void operator()(AccRef acc, const Unit& u, int wr, int wc, int fr, int fq) const {
        const int row0 = u.pm * 256 + wr * 64 + fr, col0 = u.pn * 256 + wc * 32 + 8 * fq;
        f32x4 gn[2][2];
#pragma unroll
        for (int bj = 0; bj < 2; ++bj)
#pragma unroll
            for (int n = 0; n < 2; ++n) gn[bj][n] = *(const f32x4*)(gain + col0 + bj * 128 + 4 * n);
        const bf16_t* yb = y + ((size_t)(col0 >> 4) * NCHK + (row0 >> 5)) * 512 + (row0 & 31) * 16 + (col0 & 15);
#pragma unroll
        for (int ai = 0; ai < 2; ++ai) {
            u32x4 yv[4][2];
#pragma unroll
            for (int m = 0; m < 4; ++m)
#pragma unroll
                for (int bj = 0; bj < 2; ++bj) yv[m][bj] = *(const u32x4*)(yb + (size_t)bj * 8 * NCHK * 512 + (ai * 4 + (m >> 1)) * 512 + (m & 1) * 256);
#pragma unroll
            for (int m = 0; m < 4; ++m) { const int row = row0 + ai * 128 + m * 16; float ss = 0.f;
#pragma unroll
                for (int bj = 0; bj < 2; ++bj) { const u32x4 q = yv[m][bj]; const f32x4 v0 = acc[ai][bj][m][0], v1 = acc[ai][bj][m][1];
                    f32x4 a, b; a[0] = bflo(q.x) * sigmoid_f(v0[0]); a[1] = bfhi(q.x) * sigmoid_f(v0[1]); a[2] = bflo(q.y) * sigmoid_f(v0[2]); a[3] = bfhi(q.y) * sigmoid_f(v0[3]);
                    b[0] = bflo(q.z) * sigmoid_f(v1[0]); b[1] = bfhi(q.z) * sigmoid_f(v1[1]); b[2] = bflo(q.w) * sigmoid_f(v1[2]); b[3] = bfhi(q.w) * sigmoid_f(v1[3]);
                    ss += a[0] * a[0] + a[1] * a[1] + a[2] * a[2] + a[3] * a[3] + b[0] * b[0] + b[1] * b[1] + b[2] * b[2] + b[3] * b[3];
                    a *= gn[bj][0]; b *= gn[bj][1];
                    u32x4 w; w.x = cvt_pk_bf16(a[0], a[1]); w.y = cvt_pk_bf16(a[2], a[3]); w.z = cvt_pk_bf16(b[0], b[1]); w.w = cvt_pk_bf16(b[2], b[3]);
                    *(u32x4*)(h + (size_t)row * DM + col0 + bj * 128) = w; }
                ss += __shfl_xor(ss, 16); ss += __shfl_xor(ss, 32); if (fq == 0) unsafeAtomicAdd(rssa + row, ss); }
            asm volatile("" ::: "memory");
        }
    }
};
struct EpiSpatial {
    static constexpr bool PERM = true, MIDSCALE = false;
    const bf16_t* ugm; const float* bsp; bf16_t* h; const float* gain; float* rssb;
    __device__ __forceinline__ void operator()(AccRef acc, const Unit& u, int wr, int wc, int fr, int fq) const {
        const int row0 = u.pm * 256 + wr * 64 + fr, col0 = u.pn * 256 + wc * 32 + 8 * fq, cc = wc * 32 + 8 * fq;
        const int q0 = row0 & 127;
        const bf16_t* up = ugm + ((size_t)(u.pn * 2) * 128 + q0) * 512 + cc;
        float bqv[2][4]; f32x4 gg[2][2];
#pragma unroll
        for (int ai = 0; ai < 2; ++ai) { gg[ai][0] = *(const f32x4*)(gain + (u.pm * 2 + ai) * 128 + cc); gg[ai][1] = *(const f32x4*)(gain + (u.pm * 2 + ai) * 128 + cc + 4);
#pragma unroll
            for (int m = 0; m < 4; ++m) bqv[ai][m] = bsp[(u.pm * 2 + ai) * 128 + q0 + m * 16]; }
#pragma unroll
        for (int ai = 0; ai < 2; ++ai) {
            const int hh = u.pm * 2 + ai;
            const f32x4 g0 = gg[ai][0], g1 = gg[ai][1];
            u32x4 uv[4][2];
#pragma unroll
            for (int m = 0; m < 4; ++m)
#pragma unroll
                for (int bj = 0; bj < 2; ++bj) uv[m][bj] = *(const u32x4*)(up + (size_t)(bj * 128 + m * 16) * 512 + hh * 128);
#pragma unroll
            for (int m = 0; m < 4; ++m) { const int q = q0 + m * 16; const float bq = bqv[ai][m];
#pragma unroll
                for (int bj = 0; bj < 2; ++bj) { const size_t tok = (size_t)(u.pn * 2 + bj) * 128 + q;
                    const u32x4 w0 = uv[m][bj]; const f32x4 v0 = acc[ai][bj][m][0], v1 = acc[ai][bj][m][1];
                    f32x4 a, b; a[0] = bflo(w0.x) * (v0[0] + bq); a[1] = bfhi(w0.x) * (v0[1] + bq); a[2] = bflo(w0.y) * (v0[2] + bq); a[3] = bfhi(w0.y) * (v0[3] + bq);
                    b[0] = bflo(w0.z) * (v1[0] + bq); b[1] = bfhi(w0.z) * (v1[1] + bq); b[2] = bflo(w0.w) * (v1[2] + bq); b[3] = bfhi(w0.w) * (v1[3] + bq);
                    float ss = a[0] * a[0] + a[1] * a[1] + a[2] * a[2] + a[3] * a[3] + b[0] * b[0] + b[1] * b[1] + b[2] * b[2] + b[3] * b[3];
                    a *= g0; b *= g1;
                    u32x4 w; w.x = cvt_pk_bf16(a[0], a[1]); w.y = cvt_pk_bf16(a[2], a[3]); w.z = cvt_pk_bf16(b[0], b[1]); w.w = cvt_pk_bf16(b[2], b[3]);
                    *(u32x4*)(h + tok * DM + 512 + hh * 128 + cc) = w;
                    ss += __shfl_xor(ss, 16); ss += __shfl_xor(ss, 32); if (fq == 0) unsafeAtomicAdd(rssb + tok, ss); } }
            asm volatile("" ::: "memory");
        }
    }
};

__device__ __forceinline__ void transpose_job(LAS unsigned char* lds, const float* src, int Kd, int Nd, bf16_t* dst, int mode) {
    LAS bf16_t* T = (LAS bf16_t*)lds;
    const int tid = threadIdx.x, nkt = Kd / 64, nnt = Nd / 64, ntile = nkt * nnt;
    for (int it = blockIdx.x; it < ntile; it += gridDim.x) {
        const int kt = it % nkt, ntl = it / nkt, k0 = kt * 64, n0 = ntl * 64;
        int n0d = n0;
        if (mode == 1) { const int j = n0 < DFF ? n0 : n0 - DFF; n0d = (j >> 7) * 256 + (j & 127) + (n0 < DFF ? 0 : 128); }
        __syncthreads();
#pragma unroll
        for (int i = 0; i < 8; ++i) { const int e = tid + i * 512, kl = e >> 6, nl = e & 63; T[nl * 66 + kl] = f2bf(src[(size_t)(k0 + kl) * Nd + n0 + nl]); }
        __syncthreads();
#pragma unroll
        for (int i = 0; i < 4; ++i) { const int e = tid + i * 512, nl = e >> 5, kp = e & 31; *(unsigned*)(dst + (size_t)(n0d + nl) * Kd + k0 + 2 * kp) = *(const LAS unsigned*)(T + nl * 66 + 2 * kp); }
    }
    __syncthreads();
}
__device__ __forceinline__ void s5_pow(float lre, float lim, double dt, int tau, double& er, double& ei) {
    const double m = exp((double)lre * dt * (double)tau), a = (double)lim * dt * (double)tau; double s, c; sincos(a, &s, &c); er = m * c; ei = m * s;
}
__device__ __forceinline__ void s5_f(float lre, float lim, double dt, double& fr, double& fi) {
    double ar, ai; s5_pow(lre, lim, dt, 1, ar, ai); const double nr = ar - 1.0, ni = ai, lr = (double)lre, li = (double)lim, den = lr * lr + li * li;
    fr = (nr * lr + ni * li) / den; fi = (ni * lr - nr * li) / den;
}

__device__ __forceinline__ void phase0(const P& p, LAS unsigned char* lds) {
    const int tid = threadIdx.x, G = gridDim.x, bid = blockIdx.x;
    unsigned char* ws = p.ws;
    {
        LAS float* S = (LAS float*)lds;
        float* MOD = (float*)(ws + WS_MOD);
        const float* wada = p.in[4]; const float* bada = p.in[5];
        for (int it = bid; it < 576; it += G) {
            const int cb = it % 36, kc = it / 36;
            __syncthreads();
            for (int e = tid; e < 1024; e += 512) { const int b = e >> 6, k = e & 63; const float* c = b < 8 ? p.in[2] + b * 1024 : p.in[3] + (b - 8) * 1024; const float v = c[kc * 64 + k]; S[e] = silu_f(v); }
            __syncthreads();
            const int col = cb * 256 + (tid & 255), kh = tid >> 8;
            float acc[16];
#pragma unroll
            for (int b = 0; b < 16; ++b) acc[b] = 0.f;
#pragma unroll 8
            for (int kk = 0; kk < 32; ++kk) { const int k = kh * 32 + kk; const float w = wada[(size_t)(kc * 64 + k) * 9216 + col];
#pragma unroll
                for (int b = 0; b < 16; ++b) acc[b] += S[b * 64 + k] * w; }
            if (kc == 0 && kh == 0) { const float bb = bada[col];
#pragma unroll
                for (int b = 0; b < 16; ++b) acc[b] += bb; }
#pragma unroll
            for (int b = 0; b < 16; ++b) unsafeAtomicAdd(MOD + b * 9216 + col, acc[b]);
        }
        __syncthreads();
    }
    transpose_job(lds, p.in[7], DM, NIN, (bf16_t*)(ws + WS_WIN1), 1);
    transpose_job(lds, p.in[35], DM, NIN, (bf16_t*)(ws + WS_WIN2), 1);
    transpose_job(lds, p.in[8], DFF, DM, (bf16_t*)(ws + WS_WOUT1), 0);
    transpose_job(lds, p.in[36], DFF, DM, (bf16_t*)(ws + WS_WOUT2), 0);
    transpose_job(lds, p.in[10], DM, NMIX, (bf16_t*)(ws + WS_WMIXIN), 0);
    transpose_job(lds, p.in[26], 512, 512, (bf16_t*)(ws + WS_WGLU), 0);
    transpose_job(lds, p.in[33], DM, DM, (bf16_t*)(ws + WS_WMIXOUT), 0);
    {
        bf16_t* wbd = (bf16_t*)(ws + WS_WBD); const float* wsp = p.in[29];
        for (int i = bid * 512 + tid; i < 512 * 64; i += G * 512) {
            const int kg = i & 63, row = i >> 6, h = row >> 7, q = row & 127, col0 = kg * 8, hp = col0 >> 7, k0 = col0 & 127;
            u32x4 w = (u32x4){0u, 0u, 0u, 0u};
            if (h == hp) { const float* s = wsp + ((size_t)h * 128 + q) * 128 + k0; const f32x4 a = *(const f32x4*)s, b = *(const f32x4*)(s + 4);
                w.x = cvt_pk_bf16(a[0], a[1]); w.y = cvt_pk_bf16(a[2], a[3]); w.z = cvt_pk_bf16(b[0], b[1]); w.w = cvt_pk_bf16(b[2], b[3]); }
            *(u32x4*)(wbd + (size_t)row * 512 + col0) = w;
        }
    }
    {
        LAS float* EBr = (LAS float*)lds; LAS float* EBi = EBr + 1024;
        float* klag = (float*)(ws + WS_KLAG);
        for (int it = bid; it < NGRP * 63; it += G) {
            const int g = it / 63, l = it % 63;
            float accv = 0.f;
            for (int dir = 0; dir < 2; ++dir) {
                if ((dir == 0 && l > 31) || (dir == 1 && l < 31)) continue;
                const int tau = dir == 0 ? 31 - l : l - 31; const int o = dir * 7;
                const float* lre = p.in[11 + o]; const float* lim = p.in[12 + o]; const float* lst = p.in[13 + o];
                const float* bre = p.in[14 + o]; const float* bim = p.in[15 + o]; const float* cre = p.in[16 + o]; const float* cim = p.in[17 + o];
                const double dt = exp((double)lst[g]);
                __syncthreads();
                for (int idx = tid; idx < 1024; idx += 512) { const int pp = idx >> 4, hp = idx & 15; const float a = lre[g * 64 + pp], b = lim[g * 64 + pp];
                    double er, ei, fr, fi; s5_pow(a, b, dt, tau, er, ei); s5_f(a, b, dt, fr, fi);
                    const double gr = er * fr - ei * fi, gi = er * fi + ei * fr; const double br = bre[(g * 64 + pp) * 16 + hp], bi = bim[(g * 64 + pp) * 16 + hp];
                    EBr[idx] = (float)(gr * br - gi * bi); EBi[idx] = (float)(gr * bi + gi * br); }
                __syncthreads();
                if (tid < 256) { const int h = tid >> 4, hp = tid & 15; const float* cr = cre + (g * 16 + h) * 64; const float* ci = cim + (g * 16 + h) * 64; float s = 0.f;
                    for (int pp = 0; pp < 64; ++pp) s += cr[pp] * EBr[pp * 16 + hp] - ci[pp] * EBi[pp * 16 + hp];
                    accv += s; }
            }
            if (tid < 256) { const int h = tid >> 4, hp = tid & 15; if (l == 31 && h == hp) accv += p.in[25][g * 16 + h]; klag[((size_t)g * 63 + l) * 256 + tid] = accv; }
        }
        __syncthreads();
    }
    {
        bf16_t* w1s = (bf16_t*)(ws + WS_W1S); bf16_t* w2s = (bf16_t*)(ws + WS_W2S);
        for (int it = bid; it < NGRP * 2 * 32; it += G) {
            const int t = it & 31, dir = (it >> 5) & 1, g = it >> 6; const int o = dir * 7;
            const int pp = tid & 63, hh = tid >> 6;
            const float a = p.in[11 + o][g * 64 + pp], b = p.in[12 + o][g * 64 + pp]; const double dt = exp((double)p.in[13 + o][g]);
            double e1r, e1i, e2r, e2i, fr, fi;
            s5_pow(a, b, dt, dir == 0 ? 31 - t : t, e1r, e1i); s5_pow(a, b, dt, dir == 0 ? t + 1 : 32 - t, e2r, e2i); s5_f(a, b, dt, fr, fi);
            const double gr = e1r * fr - e1i * fi, gi = e1r * fi + e1i * fr;
#pragma unroll
            for (int j = 0; j < 2; ++j) { const int h = 2 * hh + j;
                const double br = p.in[14 + o][(g * 64 + pp) * 16 + h], bi = p.in[15 + o][(g * 64 + pp) * 16 + h];
                w1s[((size_t)g * 256 + dir * 128 + pp) * 512 + t * 16 + h] = f2bf((float)(gr * br - gi * bi));
                w1s[((size_t)g * 256 + dir * 128 + 64 + pp) * 512 + t * 16 + h] = f2bf((float)(gr * bi + gi * br));
                const double cr = p.in[16 + o][(g * 16 + h) * 64 + pp], ci = p.in[17 + o][(g * 16 + h) * 64 + pp];
                w2s[((size_t)g * 512 + t * 16 + h) * KS2 + 512 + dir * 128 + pp] = f2bf((float)(cr * e2r - ci * e2i));
                w2s[((size_t)g * 512 + t * 16 + h) * KS2 + 512 + dir * 128 + 64 + pp] = f2bf((float)(-(cr * e2i + ci * e2r))); }
        }
    }
}

__device__ __forceinline__ void pass_modnorm_in(const P& p, const float* gain, int shidx) {
    const int lane = threadIdx.x & 63, wave = threadIdx.x >> 6;
    const float* MOD = (const float*)(p.ws + WS_MOD); bf16_t* H = (bf16_t*)(p.ws + WS_H);
    const int stride = gridDim.x * 8;
    for (int row = blockIdx.x * 8 + wave; row < MT; row += 2 * stride) {
        const int row2 = row + stride;
        const bool has2 = row2 < MT;
        const float* s0 = row < MP ? p.in[0] + (size_t)row * DM : p.in[1] + (size_t)(row - MP) * DM;
        const int r2 = has2 ? row2 : row;
        const float* s1 = r2 < MP ? p.in[0] + (size_t)r2 * DM : p.in[1] + (size_t)(r2 - MP) * DM;
        f32x4 v[4], w[4]; float ss = 0.f, tt = 0.f;
#pragma unroll
        for (int i = 0; i < 4; ++i) { v[i] = *(const f32x4*)(s0 + i * 256 + lane * 4); w[i] = *(const f32x4*)(s1 + i * 256 + lane * 4); }
#pragma unroll
        for (int i = 0; i < 4; ++i) { ss += v[i][0] * v[i][0] + v[i][1] * v[i][1] + v[i][2] * v[i][2] + v[i][3] * v[i][3]; tt += w[i][0] * w[i][0] + w[i][1] * w[i][1] + w[i][2] * w[i][2] + w[i][3] * w[i][3]; }
        ss = wave_sum(ss); tt = wave_sum(tt);
        const float rs0 = rsqrtf(ss * (1.0f / DM) + EPS), rs1 = rsqrtf(tt * (1.0f / DM) + EPS);
        const float* sh0 = MOD + (size_t)batch_of_row(row) * 9216 + shidx * 1024; const float* sh1 = MOD + (size_t)batch_of_row(r2) * 9216 + shidx * 1024;
#pragma unroll
        for (int i = 0; i < 4; ++i) { const int c = i * 256 + lane * 4; const f32x4 g4 = *(const f32x4*)(gain + c);
            { const f32x4 s4 = *(const f32x4*)(sh0 + 1024 + c), h4 = *(const f32x4*)(sh0 + c); const f32x4 o = v[i] * rs0 * g4 * (s4 + 1.0f) + h4; u32x2 q; q.x = cvt_pk_bf16(o[0], o[1]); q.y = cvt_pk_bf16(o[2], o[3]); *(u32x2*)(H + (size_t)row * DM + c) = q; }
            if (has2) { const f32x4 s4 = *(const f32x4*)(sh1 + 1024 + c), h4 = *(const f32x4*)(sh1 + c); const f32x4 o = w[i] * rs1 * g4 * (s4 + 1.0f) + h4; u32x2 q; q.x = cvt_pk_bf16(o[0], o[1]); q.y = cvt_pk_bf16(o[2], o[3]); *(u32x2*)(H + (size_t)row2 * DM + c) = q; } }
    }
}
__device__ __forceinline__ void pass_shw(const P& p, LAS unsigned char* lds, const bf16_t* Wt, int N, int shidx, float* out) {
    const int tid = threadIdx.x, lane = tid & 63, wave = tid >> 6;
    LAS float* S = (LAS float*)lds;
    const float* MOD = (const float*)(p.ws + WS_MOD);
    __syncthreads();
    for (int e = tid; e < 16 * 256; e += 512) { const int b = e >> 8, k4 = e & 255; *(LAS f32x4*)(S + b * 1024 + k4 * 4) = *(const f32x4*)(MOD + (size_t)b * 9216 + shidx * 1024 + k4 * 4); }
    __syncthreads();
    for (int n = blockIdx.x * 8 + wave; n < N; n += gridDim.x * 8) {
        float w[16];
#pragma unroll
        for (int j = 0; j < 4; ++j) { const u32x2 q = *(const u32x2*)(Wt + (size_t)n * DM + j * 256 + lane * 4); w[j * 4] = bflo(q.x); w[j * 4 + 1] = bfhi(q.x); w[j * 4 + 2] = bflo(q.y); w[j * 4 + 3] = bfhi(q.y); }
        float mine = 0.f;
#pragma unroll 1
        for (int b = 0; b < 16; ++b) { float a = 0.f;
#pragma unroll
            for (int j = 0; j < 4; ++j) { const f32x4 s4 = *(const LAS f32x4*)(S + b * 1024 + j * 256 + lane * 4); a += w[j * 4] * s4[0] + w[j * 4 + 1] * s4[1] + w[j * 4 + 2] * s4[2] + w[j * 4 + 3] * s4[3]; }
            a = wave_sum(a); if (lane == b) mine = a; }
        if (lane < 16) out[(size_t)lane * N + n] = mine;
    }
    __syncthreads();
}
__device__ __forceinline__ void pass_final(const P& p) {
    const int lane = threadIdx.x & 63, wave = threadIdx.x >> 6; const float* gain = p.in[37];
    for (int row = blockIdx.x * 8 + wave; row < MT; row += gridDim.x * 8) {
        float* src = p.out + (size_t)row * DM; f32x4 v[4]; float ss = 0.f;
#pragma unroll
        for (int i = 0; i < 4; ++i) { v[i] = *(const f32x4*)(src + i * 256 + lane * 4); ss += v[i][0] * v[i][0] + v[i][1] * v[i][1] + v[i][2] * v[i][2] + v[i][3] * v[i][3]; }
        ss = wave_sum(ss); const float rstd = rsqrtf(ss * (1.0f / DM) + EPS);
#pragma unroll
        for (int i = 0; i < 4; ++i) { const int c = i * 256 + lane * 4; *(f32x4*)(src + c) = v[i] * rstd * *(const f32x4*)(gain + c); }
    }
}
__device__ __forceinline__ void fill_kmat(const P& p) {
    const float* klag = (const float*)(p.ws + WS_KLAG); bf16_t* w2s = (bf16_t*)(p.ws + WS_W2S);
    for (int i = blockIdx.x * 512 + threadIdx.x; i < NGRP * 512 * 64; i += gridDim.x * 512) {
        const int kg = i & 63, n = (i >> 6) & 511, g = i >> 15, t = n >> 4, h = n & 15, s = kg >> 1, hp0 = (kg & 1) * 8, l = s - t + 31;
        const float* src = klag + ((size_t)g * 63 + l) * 256 + h * 16 + hp0; const f32x4 a = *(const f32x4*)src, b = *(const f32x4*)(src + 4);
        u32x4 w; w.x = cvt_pk_bf16(a[0], a[1]); w.y = cvt_pk_bf16(a[2], a[3]); w.z = cvt_pk_bf16(b[0], b[1]); w.w = cvt_pk_bf16(b[2], b[3]);
        *(u32x4*)(w2s + ((size_t)g * 512 + n) * KS2 + s * 16 + hp0) = w;
    }
}
__device__ __forceinline__ void pass_ln_transpose(const P& p, LAS unsigned char* lds) {
    const int tid = threadIdx.x;
    LAS float* ST = (LAS float*)lds;
    LAS bf16_t* T = (LAS bf16_t*)(lds + 1024);
    const bf16_t* vg = (const bf16_t*)(p.ws + WS_VG); bf16_t* vt = (bf16_t*)(p.ws + WS_VT);
    const float* lg = p.in[27]; const float* lb = p.in[28];
    for (int bn = blockIdx.x; bn < MT / 128; bn += gridDim.x) {
        __syncthreads();
        {
            const int k = tid >> 2, pp = tid & 3; const bf16_t* rp = vg + ((size_t)bn * 128 + k) * 512 + pp * 8;
            u32x4 a[16];
#pragma unroll
            for (int j = 0; j < 16; ++j) a[j] = *(const u32x4*)(rp + j * 32);
            float s = 0.f, q = 0.f;
#pragma unroll
            for (int j = 0; j < 16; ++j) { const float x0 = bflo(a[j].x), x1 = bfhi(a[j].x), x2 = bflo(a[j].y), x3 = bfhi(a[j].y), x4 = bflo(a[j].z), x5 = bfhi(a[j].z), x6 = bflo(a[j].w), x7 = bfhi(a[j].w);
                s += ((x0 + x1) + (x2 + x3)) + ((x4 + x5) + (x6 + x7)); q += ((x0 * x0 + x1 * x1) + (x2 * x2 + x3 * x3)) + ((x4 * x4 + x5 * x5) + (x6 * x6 + x7 * x7)); }
            s += __shfl_xor(s, 1); q += __shfl_xor(q, 1); s += __shfl_xor(s, 2); q += __shfl_xor(q, 2);
            const float mu = s * (1.0f / 512), var = fmaxf(q * (1.0f / 512) - mu * mu, 0.f);
            if (pp == 0) { ST[k * 2] = mu; ST[k * 2 + 1] = rsqrtf(var + EPS); }
        }
        __syncthreads();
        for (int h = 0; h < 4; ++h) {
#pragma unroll
            for (int i = 0; i < 4; ++i) { const int idx = tid + i * 512, k = idx >> 4, cg = idx & 15, c0 = cg * 8, kx = k ^ (cg << 3);
                const u32x4 a = *(const u32x4*)(vg + ((size_t)bn * 128 + k) * 512 + h * 128 + c0); const float mu = ST[k * 2], rs = ST[k * 2 + 1];
                const float x[8] = {bflo(a.x), bfhi(a.x), bflo(a.y), bfhi(a.y), bflo(a.z), bfhi(a.z), bflo(a.w), bfhi(a.w)};
                const f32x4 g0 = *(const f32x4*)(lg + h * 128 + c0), g1 = *(const f32x4*)(lg + h * 128 + c0 + 4), b0 = *(const f32x4*)(lb + h * 128 + c0), b1 = *(const f32x4*)(lb + h * 128 + c0 + 4);
#pragma unroll
                for (int j = 0; j < 4; ++j) { T[(c0 + j) * 136 + kx] = f2bf((x[j] - mu) * rs * g0[j] + b0[j]); T[(c0 + 4 + j) * 136 + kx] = f2bf((x[4 + j] - mu) * rs * g1[j] + b1[j]); } }
            __syncthreads();
#pragma unroll
            for (int i = 0; i < 4; ++i) { const int idx = tid + i * 512, c = idx >> 4, kg = idx & 15;
                *(u32x4*)(vt + (((size_t)bn * 128 + c) * 4 + h) * 128 + kg * 8) = *(const LAS u32x4*)(T + c * 136 + ((kg ^ ((c >> 3) & 15)) << 3)); }
            __syncthreads();
        }
    }
}
__device__ __forceinline__ void pass_chunk_scan(const P& p) {
    const float* sloc = (const float*)(p.ws + WS_SLOC); bf16_t* ug = (bf16_t*)(p.ws + WS_UG);
    for (int T = blockIdx.x * 512 + threadIdx.x; T < 16 * NGRP * 128; T += gridDim.x * 512) {
        const int j = T & 127, dir = j >> 6, pp = j & 63, g = (T >> 7) & 31, b = T >> 12;
        const int cb = b < 8 ? b * 64 : 512 + (b - 8) * 256, nc = b < 8 ? 64 : 256; const int o = dir * 7;
        const double dt = exp((double)p.in[13 + o][g]); double er, ei; s5_pow(p.in[11 + o][g * 64 + pp], p.in[12 + o][g * 64 + pp], dt, TCH, er, ei);
        const float ar = (float)er, ai = (float)ei;
        const float* lp = sloc + ((size_t)g * NCHK + cb) * 256 + dir * 128 + pp;
        bf16_t* up = ug + ((size_t)g * NCHK + cb) * KS2 + 512 + dir * 128 + pp;
        float sr = 0.f, si = 0.f;
        for (int c0 = 0; c0 < nc; c0 += 8) {
            float lr[8], li[8];
#pragma unroll
            for (int q = 0; q < 8; ++q) { const int c = dir == 0 ? c0 + q : nc - 1 - (c0 + q); lr[q] = lp[(size_t)c * 256]; li[q] = lp[(size_t)c * 256 + 64]; }
#pragma unroll
            for (int q = 0; q < 8; ++q) { const int c = dir == 0 ? c0 + q : nc - 1 - (c0 + q);
                up[(size_t)c * KS2] = f2bf(sr); up[(size_t)c * KS2 + 64] = f2bf(si);
                const float nr = ar * sr - ai * si + lr[q], ni = ar * si + ai * sr + li[q]; sr = nr; si = ni; }
        }
    }
}


#define XB_TMO      128
#define XB_XCNT(j)  (256  + 64 * (j))
#define XB_XSUB(j)  (1280 + 64 * (j))
#define XB_XGEN(j)  (2304 + 64 * (j))
#define XB_TOP      3328
#define XB_TOPGEN   3392
#define XCD_BAR_WORDS 3456
#define XB_SPIN_CAP (1u << 18)
__device__ __forceinline__ unsigned xb_ld(unsigned* p)              { return __hip_atomic_load(p, __ATOMIC_RELAXED, __HIP_MEMORY_SCOPE_AGENT); }
__device__ __forceinline__ unsigned xb_add(unsigned* p, unsigned v) { return __hip_atomic_fetch_add(p, v, __ATOMIC_RELAXED, __HIP_MEMORY_SCOPE_AGENT); }
__device__ __forceinline__ unsigned xb_xcc_id() { return (unsigned)__builtin_amdgcn_s_getreg((3 << 11) | 20) & 0xFu; }
#define XB_SPIN(cond, bar) do { unsigned _sp = 0; while (cond) { __builtin_amdgcn_s_sleep(1); \
    if ((++_sp & 255u) == 0u) { if (xb_ld(&(bar)[XB_TMO])) break; if (_sp > XB_SPIN_CAP) { atomicAdd(&(bar)[XB_TMO], 1u); break; } } } } while (0)
struct XcdBarrier { unsigned* bar; unsigned x; volatile LAS unsigned* st; };
__device__ __forceinline__ XcdBarrier xcd_barrier_post(unsigned* bar, volatile LAS unsigned* st) {
    XcdBarrier b; b.bar = bar; b.x = xb_xcc_id(); b.st = st;
    if (threadIdx.x == 0) (void)xb_add(&bar[XB_XCNT(b.x)], 1u);
    return b;
}
__device__ __forceinline__ void xcd_barrier_complete(unsigned* bar, unsigned x, unsigned& nloc, unsigned& nx) {
    const unsigned G = gridDim.x * gridDim.y * gridDim.z;
    unsigned sum, cnt, mine, sp = 0u;
    for (;;) {
        sum = 0u; cnt = 0u; mine = 0u;
#pragma unroll
        for (unsigned j = 0; j < 16; ++j) { const unsigned c = xb_ld(&bar[XB_XCNT(j)]); sum += c; cnt += (c > 0u) ? 1u : 0u; mine = (j == x) ? c : mine; }
        if (sum == G) break;
        __builtin_amdgcn_s_sleep(1);
        if ((++sp & 255u) == 0u) { if (xb_ld(&bar[XB_TMO])) break; if (sp > XB_SPIN_CAP) { atomicAdd(&bar[XB_TMO], 1u); break; } }
    }
    nloc = mine > 0u ? mine : 1u; nx = cnt > 0u ? cnt : 1u;
}
__device__ __forceinline__ void xcd_barrier(const XcdBarrier& b) {
    asm volatile("s_waitcnt vmcnt(0)" ::: "memory");
    __syncthreads();
    if (threadIdx.x == 0) {
        unsigned* bar = b.bar;
        __builtin_amdgcn_s_waitcnt(0);
        unsigned nloc = b.st[0], nx = b.st[1];
        if (nloc == 0u) { xcd_barrier_complete(bar, b.x, nloc, nx); b.st[0] = nloc; b.st[1] = nx; }
        const unsigned old = xb_add(&bar[XB_XSUB(b.x)], 1u);
        const unsigned gen = old / nloc;
        if (old + 1u == (gen + 1u) * nloc) {
            __builtin_amdgcn_fence(__ATOMIC_RELEASE, "agent");
            asm volatile("s_waitcnt vmcnt(0)" ::: "memory");
            const unsigned og = xb_add(&bar[XB_TOP], 1u);
            const unsigned tg = og / nx;
            if (og + 1u == (tg + 1u) * nx) xb_add(&bar[XB_TOPGEN], 1u);
            else XB_SPIN(xb_ld(&bar[XB_TOPGEN]) == tg, bar);
            __builtin_amdgcn_fence(__ATOMIC_ACQUIRE, "agent");
            xb_add(&bar[XB_XGEN(b.x)], 1u);
            asm volatile("s_waitcnt vmcnt(0)" ::: "memory");
        } else {
            XB_SPIN(xb_ld(&bar[XB_XGEN(b.x)]) == gen, bar);
            __builtin_amdgcn_fence(__ATOMIC_ACQUIRE, "agent");
            asm volatile("s_waitcnt vmcnt(0)" ::: "memory");
        }
    }
    __syncthreads();
}

__global__ void __launch_bounds__(512, 2) mega(P p) {
    extern __shared__ __attribute__((aligned(16))) unsigned char lds_raw[];
    LAS unsigned char* lds = (LAS unsigned char*)lds_raw;
    cg::grid_group grid = cg::this_grid();
    if (threadIdx.x < 4) ((volatile LAS unsigned*)(lds + LDS_STAGE))[threadIdx.x] = 0u;
    __syncthreads();
    { XcdBarrier xb0 = xcd_barrier_post((unsigned*)(p.ws + WS_BAR), (volatile LAS unsigned*)(lds + LDS_STAGE)); (void)xb0; }
    const int lo = p.ph_lo, hi = p.ph_hi, G = gridDim.x, bid = blockIdx.x;
#define B_MOD ((const float*)(p.ws + WS_MOD))
#define B_H ((bf16_t*)(p.ws + WS_H))
#define B_HID ((bf16_t*)(p.ws + WS_HID))
#define B_UG ((bf16_t*)(p.ws + WS_UG))
#define B_UGM ((bf16_t*)(p.ws + WS_UGM))
#define B_VG ((bf16_t*)(p.ws + WS_VG))
#define B_VT ((bf16_t*)(p.ws + WS_VT))
#define B_SLOC ((float*)(p.ws + WS_SLOC))
#define B_Y ((bf16_t*)(p.ws + WS_SLOC))
#define B_H2 ((bf16_t*)(p.ws + WS_H2))
#define B_RSS1 ((float*)(p.ws + WS_RSS1))
#define B_RSS2 ((float*)(p.ws + WS_RSS2))
#define B_RSSA ((float*)(p.ws + WS_RSSA))
#define B_RSSB ((float*)(p.ws + WS_RSSB))
#ifndef PHMASK
#define PHMASK 0xFFFF
#endif
#define IN(k) (((PHMASK >> (k)) & 1) && lo <= (k) && (k) < hi)
#define SYNC(k) do { if (IN(k) && IN((k) + 1)) { if (lo < 0) grid.sync(); else { unsigned char* w_ = p.ws; asm volatile("" : "+s"(w_)); XcdBarrier xb_; xb_.bar = (unsigned*)(w_ + WS_BAR); xb_.x = xb_xcc_id(); xb_.st = (volatile LAS unsigned*)(lds + LDS_STAGE); xcd_barrier(xb_); } } } while (0)
    if (IN(0)) phase0(p, lds);
    SYNC(0);
    if (IN(1)) { pass_modnorm_in(p, p.in[6], 0); fill_kmat(p);
        pass_shw(p, lds, (const bf16_t*)(p.ws + WS_WMIXIN), NMIX, 3, (float*)(p.ws + WS_SHW2)); pass_shw(p, lds, (const bf16_t*)(p.ws + WS_WIN2), NIN, 6, (float*)(p.ws + WS_SHW3)); }
    SYNC(1);
    if (IN(2)) { pg8::Gemm g{B_H, (const bf16_t*)(p.ws + WS_WIN1), DM, DM, DM, 0, 0, 0}; pg8::Order S; S.init(MT / 256, NIN / 256, 1, G, bid); EpiSwiglu<false> E{B_HID, nullptr, nullptr}; pg8::gemm_phase(lds, g, S, E); }
    SYNC(2);
    if (IN(3)) { pg8::Gemm g{B_HID, (const bf16_t*)(p.ws + WS_WOUT1), DFF, DFF, DFF, 0, 0, 0}; pg8::Order S; S.init(MT / 256, DM / 256, 1, G, bid);
        EpiResid<true, false, true> E{p.in[0], p.in[1], p.out, B_MOD + 2 * 1024, B_H, p.in[9], B_MOD + 4 * 1024, B_RSS1, nullptr, nullptr}; pg8::gemm_phase(lds, g, S, E); }
    SYNC(3);
    if (IN(4)) { pg8::Gemm g{B_H, (const bf16_t*)(p.ws + WS_WMIXIN), DM, DM, DM, 0, 0, 0}; pg8::Order S; S.init(MT / 256, NMIX / 256, 1, G, bid); EpiMixIn E{B_UG, B_UGM, B_VG, B_RSS1, (const float*)(p.ws + WS_SHW2)}; pg8::gemm_phase(lds, g, S, E); }
    SYNC(4);
    if (IN(5)) { pass_ln_transpose(p, lds);
        pg8::Gemm g{B_UG, (const bf16_t*)(p.ws + WS_W1S), KS2, 512, 512, (size_t)NCHK * KS2, (size_t)256 * 512, 0}; pg8::Order S; S.init(NCHK / 256, 1, NGRP, G, bid); EpiS1 E{B_SLOC}; pg8::gemm_phase(lds, g, S, E); }
    SYNC(5);
    if (IN(6)) { pass_chunk_scan(p);
        pg8::Gemm g{(const bf16_t*)(p.ws + WS_WBD), B_VT, 512, 512, 512, 0, 0, 0}; pg8::Order S; S.init(2, MT / 256, 1, G, bid); EpiSpatial E{B_UGM, p.in[30], B_H, p.in[32], B_RSSB}; pg8::gemm_phase(lds, g, S, E); }
    SYNC(6);
    if (IN(7)) { pg8::Gemm g{B_UG, (const bf16_t*)(p.ws + WS_W2S), KS2, KS2, KS2, (size_t)NCHK * KS2, (size_t)512 * KS2, 0}; pg8::Order S; S.init(NCHK / 256, 2, NGRP, G, bid); EpiS2 E{B_Y}; pg8::gemm_phase(lds, g, S, E); }
    SYNC(7);
    if (IN(8)) { pg8::Gemm g{B_Y, (const bf16_t*)(p.ws + WS_WGLU), 512, 512, 512, 0, 0, 1}; pg8::Order S; S.init(MT / 256, 2, 1, G, bid); EpiGlu E{B_Y, B_H, p.in[31], B_RSSA}; pg8::gemm_phase(lds, g, S, E); }
    SYNC(8);
    if (IN(9)) { pg8::Gemm g{B_H, (const bf16_t*)(p.ws + WS_WMIXOUT), DM, DM, DM, 0, 0, 0}; pg8::Order S; S.init(MT / 256, DM / 256, 1, G, bid);
        EpiResid<true, true, false> E{p.out, p.out + (size_t)MP * DM, p.out, B_MOD + 5 * 1024, B_H2, p.in[34], B_MOD + 7 * 1024, B_RSS2, B_RSSA, B_RSSB}; pg8::gemm_phase(lds, g, S, E); }
    SYNC(9);
    if (IN(10)) { pg8::Gemm g{B_H2, (const bf16_t*)(p.ws + WS_WIN2), DM, DM, DM, 0, 0, 0}; pg8::Order S; S.init(MT / 256, NIN / 256, 1, G, bid); EpiSwiglu<true> E{B_HID, B_RSS2, (const float*)(p.ws + WS_SHW3)}; pg8::gemm_phase(lds, g, S, E); }
    SYNC(10);
    if (IN(11)) { pg8::Gemm g{B_HID, (const bf16_t*)(p.ws + WS_WOUT2), DFF, DFF, DFF, 0, 0, 0}; pg8::Order S; S.init(MT / 256, DM / 256, 1, G, bid);
        EpiResidFinal E{p.out, p.out, B_MOD + 8 * 1024, p.in[37], (float*)(p.ws + WS_RSS3), (unsigned*)(p.ws + WS_PCNT)}; pg8::gemm_phase(lds, g, S, E); }
#undef IN
#undef SYNC
}

extern "C" void kernel_launch(void* const* d_in, const int* in_sizes, int n_in, void* d_out, int out_size, void* d_ws, size_t ws_size, hipStream_t stream) {
    static int grid = 0;
    if (grid == 0) {
        if (n_in != 38 || out_size != MT * DM || ws_size < WS_END) { fprintf(stderr, "kernel_launch: unexpected shapes: n_in %d out %d ws %zu (need %zu)\n", n_in, out_size, ws_size, (size_t)WS_END); grid = -1; return; }
        int dev = 0, cus = 0, per_cu = 0;
        (void)hipGetDevice(&dev); (void)hipDeviceGetAttribute(&cus, hipDeviceAttributeMultiprocessorCount, dev);
        if (hipFuncSetAttribute((const void*)mega, hipFuncAttributeMaxDynamicSharedMemorySize, LDS_BYTES) != hipSuccess) { fprintf(stderr, "kernel_launch: hipFuncSetAttribute failed\n"); grid = -1; return; }
        (void)hipOccupancyMaxActiveBlocksPerMultiprocessor(&per_cu, (const void*)mega, 512, LDS_BYTES);
        if (per_cu < 1) per_cu = 1;
        grid = cus * 1;
        (void)hipGetLastError();
        fprintf(stderr, "kernel_launch: cus %d per_cu %d grid %d ws need %zu have %zu\n", cus, per_cu, grid, (size_t)WS_END, ws_size);
    }
    if (grid < 0) return;
    (void)hipMemsetAsync((char*)d_ws + WS_MOD, 0, ZERO_BYTES, stream);
    P p{};
    for (int i = 0; i < 38; ++i) p.in[i] = (const float*)d_in[i];
    p.out = (float*)d_out; p.ws = (unsigned char*)d_ws;
#if N_LAUNCH_MODE == 0
    p.ph_lo = 0; p.ph_hi = NPHASE;
    void* args[] = {&p};
    hipError_t e = hipLaunchCooperativeKernel((const void*)mega, dim3(grid), dim3(512), args, LDS_BYTES, stream);
    if (e != hipSuccess) fprintf(stderr, "cooperative launch failed: %s (grid %d)\n", hipGetErrorString(e), grid);
#else
    for (int k = 0; k < NPHASE; ++k) { p.ph_lo = k; p.ph_hi = k + 1; hipLaunchKernelGGL(mega, dim3(grid), dim3(512), LDS_BYTES, stream, p); }
#endif
}
```

```cpp
#include <hip/hip_runtime.h>
#include <hip/hip_cooperative_groups.h>
#include <cstdio>
namespace cg = cooperative_groups;

#define LAS __attribute__((address_space(3)))
typedef unsigned short bf16_t;
typedef short bf16x8 __attribute__((ext_vector_type(8)));
typedef float f32x4 __attribute__((ext_vector_type(4)));
typedef unsigned u32x4 __attribute__((ext_vector_type(4)));
typedef unsigned u32x2 __attribute__((ext_vector_type(2)));

#ifndef N_LAUNCH_MODE
#define N_LAUNCH_MODE 0
#endif

constexpr int MT = 81920;
constexpr int MP = 16384;
constexpr int DM = 1024, DFF = 2816, NIN = 5632, NMIX = 1536;
constexpr int NGRP = 32, TCH = 32, NCHK = MT / TCH  , KS2 = 768;
constexpr float EPS = 1e-6f;
constexpr int NPHASE = 12;

constexpr size_t al256(size_t x) { return (x + 255) & ~(size_t)255; }
constexpr size_t WS_MOD = 0;
constexpr size_t MOD_BYTES = 16 * 9216 * 4;
constexpr size_t WS_RSS1 = WS_MOD + MOD_BYTES;
constexpr size_t WS_RSS2 = WS_RSS1 + (size_t)MT * 4;
constexpr size_t WS_RSSA = WS_RSS2 + (size_t)MT * 4;
constexpr size_t WS_RSSB = WS_RSSA + (size_t)MT * 4;
constexpr size_t WS_RSS3 = WS_RSSB + (size_t)MT * 4;
constexpr size_t WS_PCNT = WS_RSS3 + (size_t)MT * 4;
constexpr size_t WS_BAR = WS_PCNT + (size_t)640 * 256;
constexpr size_t ZERO_BYTES = WS_BAR + 3456 * 4;
constexpr size_t WS_SHW2 = ZERO_BYTES;
constexpr size_t WS_SHW3 = WS_SHW2 + 16 * 1536 * 4;
constexpr size_t WS_WIN1 = al256(WS_SHW3 + 16 * 5632 * 4);
constexpr size_t WS_WIN2 = WS_WIN1 + (size_t)NIN * DM * 2;
constexpr size_t WS_WOUT1 = WS_WIN2 + (size_t)NIN * DM * 2;
constexpr size_t WS_WOUT2 = WS_WOUT1 + (size_t)DM * DFF * 2;
constexpr size_t WS_WMIXIN = WS_WOUT2 + (size_t)DM * DFF * 2;
constexpr size_t WS_WGLU = WS_WMIXIN + (size_t)NMIX * DM * 2;
constexpr size_t WS_WMIXOUT = WS_WGLU + 512 * 512 * 2;
constexpr size_t WS_WBD = WS_WMIXOUT + (size_t)DM * DM * 2;
constexpr size_t WS_KLAG = WS_WBD + 512 * 512 * 2;
constexpr size_t WS_W1S = WS_KLAG + (size_t)NGRP * 63 * 256 * 4;
constexpr size_t WS_W2S = WS_W1S + (size_t)NGRP * 256 * 512 * 2;
constexpr size_t WS_H = WS_W2S + (size_t)NGRP * 512 * KS2 * 2;
constexpr size_t WS_H2 = WS_H + (size_t)MT * DM * 2;
constexpr size_t WS_R = WS_H2 + (size_t)MT * DM * 2;
constexpr size_t WS_HID = WS_R;
constexpr size_t WS_UG = WS_R;
constexpr size_t WS_UGM = WS_UG + (size_t)NGRP * NCHK * KS2 * 2;
constexpr size_t WS_VG = WS_UGM + (size_t)MT * 512 * 2;
constexpr size_t WS_VT = WS_VG + (size_t)MT * 512 * 2;
constexpr size_t WS_SLOC = WS_VT + (size_t)MT * 512 * 2;
constexpr size_t WS_END = WS_R + (size_t)MT * DFF * 2;
static_assert(WS_SLOC + (size_t)NGRP * NCHK * 256 * 4 <= WS_END, "mixer buffers must fit the HID region");

constexpr int LDS_STAGE = 131072;
constexpr int LDS_BYTES = LDS_STAGE + 16;

struct P { const float* in[38]; float* out; unsigned char* ws; int ph_lo, ph_hi; };

__device__ __forceinline__ unsigned cvt_pk_bf16(float lo, float hi) { unsigned r; asm volatile("v_cvt_pk_bf16_f32 %0, %1, %2" : "=v"(r) : "v"(lo), "v"(hi)); return r; }
__device__ __forceinline__ bf16_t f2bf(float f) { return (bf16_t)(cvt_pk_bf16(f, 0.f) & 0xffffu); }
__device__ __forceinline__ float bflo(unsigned w) { return __uint_as_float(w << 16); }
__device__ __forceinline__ float bfhi(unsigned w) { return __uint_as_float(w & 0xffff0000u); }
__device__ __forceinline__ float wave_sum(float v) {
#pragma unroll
    for (int o = 32; o; o >>= 1) v += __shfl_xor(v, o);
    return v;
}
__device__ __forceinline__ float sigmoid_f(float a) { return __builtin_amdgcn_rcpf(1.f + __expf(-a)); }
__device__ __forceinline__ float gelu_f(float x) { return x * sigmoid_f(1.5957691216f * (x + 0.044715f * x * x * x)); }
__device__ __forceinline__ float silu_f(float x) { return x * sigmoid_f(x); }
__device__ __forceinline__ int batch_of_row(int row) { return row < MP ? (row >> 11) : 8 + ((row - MP) >> 13); }
__device__ __forceinline__ int batch_of_tile(int pm) { return pm < 64 ? (pm >> 3) : 8 + ((pm - 64) >> 5); }

namespace pg8 {
constexpr int BM = 256, BK = 64, HALF = 128, HTB = HALF * BK * 2, NXCD = 8, WGM = 8;
__device__ __forceinline__ int lds_byte(int r, int c) { const int st = (r >> 4) * 2 + (c >> 5), rr = r & 15, cc = c & 31, ob = rr * 64 + cc * 2; return st * 1024 + (ob ^ (((ob >> 9) & 1) << 5)); }
__device__ __forceinline__ void stage_rc(int b, int& R, int& C) { const int st = b / 1024, sb = b % 1024, swz = sb ^ (((sb >> 9) & 1) << 5); R = (st >> 1) * 16 + swz / 64; C = (st & 1) * 32 + (swz % 64) / 2; }
__device__ __forceinline__ int perm32(int rho) { const int n = rho >> 4, i = rho & 15; return 8 * (i >> 2) + 4 * n + (i & 3); }

__device__ __forceinline__ const char* uni_ptr(const char* q) { const unsigned long long v = (unsigned long long)q; const unsigned lo = __builtin_amdgcn_readfirstlane((unsigned)v), hi = __builtin_amdgcn_readfirstlane((unsigned)(v >> 32)); return (const char*)(((unsigned long long)hi << 32) | lo); }
struct Unit { int pm, pn, g; };
struct Gemm { const bf16_t* A; const bf16_t* Bt; int lda, ldb, K; size_t gsA, gsB; int amode; };
struct Order {
    int nM, nN, ntot, G, c, imax;
    __device__ void init(int nM_, int nN_, int nG_, int G_, int c_) { nM = nM_; nN = nN_; ntot = nM_ * nN_ * nG_; G = G_; c = c_; imax = 1 << 30; }
    __device__ bool next(int i, Unit& u) const {
        const long L = (long)i * G + c; if (L >= ntot || i >= imax) return false;
        int wgid = (int)L; { const int q = ntot / NXCD, r = ntot % NXCD, xcd = wgid % NXCD, off = wgid / NXCD; wgid = (xcd < r ? xcd * (q + 1) : r * (q + 1) + (xcd - r) * q) + off; }
        const int per = nM * nN; u.g = wgid / per; const int w = wgid - u.g * per;
        const int nig = WGM * nN, gid = w / nig, fm = gid * WGM, gsz = (nM - fm) < WGM ? (nM - fm) : WGM;
        u.pm = fm + ((w % nig) % gsz); u.pn = (w % nig) / gsz; return true;
    }
};

template <class Epi>
__device__ __forceinline__ void gemm_phase(LAS unsigned char* lds, const Gemm g, const Order& S, const Epi& E) {
    int tid_ = threadIdx.x; asm volatile("" : "+v"(tid_));
    const int tid = tid_, wid = __builtin_amdgcn_readfirstlane(tid >> 6), lane = tid & 63, wr = wid >> 2, wc = wid & 3, fr = lane & 15, fq = lane >> 4;
    const int K = g.K, nt = K / BK;
    unsigned voffA[2], voffB[2];
#pragma unroll
    for (int i = 0; i < 2; ++i) { int R, C; stage_rc(tid * 16 + i * 8192, R, C); const int Rb = Epi::PERM ? ((R & ~31) + perm32(R & 31)) : R;
        voffA[i] = g.amode ? (unsigned)((C >> 4) * (2560 * 512) + (R >> 5) * 512 + (R & 31) * 16 + (C & 15)) * 2u : (unsigned)(R * g.lda + C) * 2u; voffB[i] = (unsigned)(Rb * g.ldb + C) * 2u; }
    const size_t kstep = (size_t)(BK * 2), kstepA = g.amode ? (size_t)4 * 2560 * 512 * 2 : kstep;
    const size_t hstepA = g.amode ? (size_t)4 * 512 * 2 : (size_t)HALF * g.lda * 2, hstepB = (size_t)HALF * g.ldb * 2;
    const size_t tstepA = 2 * hstepA, tstepB = 2 * hstepB;
    const unsigned ldsw = (unsigned)wid * 1024u;
    const int aoff = lds_byte(wr * 64 + fr, fq * 8), boff = lds_byte(wc * 32 + fr, fq * 8);
#define PG8_SA(b, h) (((b) * 2 + (h)) * HTB)
#define PG8_SB(b, h) ((4 + (b) * 2 + (h)) * HTB)
#define PG8_STAGE(bufoff, gbase, voff) do { _Pragma("unroll") for (int _i = 0; _i < 2; ++_i) \
        __builtin_amdgcn_global_load_lds((const unsigned*)((const char*)(gbase) + (voff)[_i]), (LAS unsigned*)(lds + (bufoff) + ldsw + _i * 8192), 16, 0, 0); } while (0)
#define PG8_LDA(dst, b, h) do { _Pragma("unroll") for (int m = 0; m < 4; ++m) _Pragma("unroll") for (int k = 0; k < 2; ++k) dst[m][k] = *(const LAS bf16x8*)(lds + PG8_SA(b, h) + aoff + m * 2048 + k * 1024); } while (0)
#define PG8_LDB(dst, b, h) do { _Pragma("unroll") for (int n = 0; n < 2; ++n) _Pragma("unroll") for (int k = 0; k < 2; ++k) dst[n][k] = *(const LAS bf16x8*)(lds + PG8_SB(b, h) + boff + n * 2048 + k * 1024); } while (0)
#define PG8_MMA(ai, bj, At, Bt) do { __builtin_amdgcn_s_setprio(1); _Pragma("unroll") for (int m = 0; m < 4; ++m) _Pragma("unroll") for (int n = 0; n < 2; ++n) _Pragma("unroll") for (int k = 0; k < 2; ++k) \
        acc[ai][bj][m][n] = __builtin_amdgcn_mfma_f32_16x16x32_bf16(Bt[n][k], At[m][k], acc[ai][bj][m][n], 0, 0, 0); __builtin_amdgcn_s_setprio(0); } while (0)
#define PG8_WAIT_V(n) asm volatile("s_waitcnt vmcnt(" #n ")" ::: "memory")
#define PG8_WAIT_L(n) asm volatile("s_waitcnt lgkmcnt(" #n ")" ::: "memory")
#define PG8_BAR __builtin_amdgcn_s_barrier()
#define PG8_SCHED __builtin_amdgcn_sched_barrier(0)
#define PG8_BASEA(u) uni_ptr((const char*)g.A + ((size_t)(u).g * g.gsA) * 2 + (size_t)(u).pm * tstepA)
#define PG8_BASEB(u) uni_ptr((const char*)g.Bt + ((size_t)(u).g * g.gsB) * 2 + (size_t)(u).pn * tstepB)
    Unit cur, nxt; int ui = 0;
    if (!S.next(0, cur)) return;
    f32x4 acc[2][2][4][2];
#pragma unroll
    for (int a = 0; a < 2; ++a)
#pragma unroll
        for (int b = 0; b < 2; ++b)
#pragma unroll
            for (int m = 0; m < 4; ++m)
#pragma unroll
                for (int n = 0; n < 2; ++n) acc[a][b][m][n] = (f32x4){0.f, 0.f, 0.f, 0.f};
    bf16x8 At[4][2], B0[2][2], B1[2][2];
    const char* cA = PG8_BASEA(cur); const char* cB = PG8_BASEB(cur);
    PG8_STAGE(PG8_SB(0, 0), cB, voffB); PG8_STAGE(PG8_SA(0, 0), cA, voffA); PG8_STAGE(PG8_SB(0, 1), cB + hstepB, voffB); PG8_STAGE(PG8_SA(0, 1), cA + hstepA, voffA);
    if (wr == 1) PG8_BAR;
    PG8_WAIT_V(4); PG8_BAR;
    PG8_STAGE(PG8_SB(1, 0), cB + kstep, voffB); PG8_STAGE(PG8_SA(1, 0), cA + kstepA, voffA); PG8_STAGE(PG8_SB(1, 1), cB + hstepB + kstep, voffB);
    PG8_WAIT_V(6); PG8_BAR;
    for (;;) {
        const bool has_next = S.next(ui + 1, nxt);
        const char* nA = has_next ? PG8_BASEA(nxt) : cA; const char* nB = has_next ? PG8_BASEB(nxt) : cB;
        for (int t = 0; t < nt; t += 2) {
            const bool last = (t == nt - 2);
            const char* a1 = cA + (size_t)(t + 1) * kstepA;
            const char* a2 = last ? nA : cA + (size_t)(t + 2) * kstepA; const char* b2 = last ? nB : cB + (size_t)(t + 2) * kstep;
            const char* a3 = a2 + kstepA; const char* b3 = b2 + kstep;
            if constexpr (Epi::MIDSCALE) { if (t == 8) E.midscale(acc, cur, wr, fr); }
            PG8_LDB(B0, 0, 0); PG8_SCHED; PG8_LDA(At, 0, 0); PG8_STAGE(PG8_SA(1, 1), a1 + hstepA, voffA);
            PG8_WAIT_L(8); PG8_BAR; PG8_WAIT_L(0); PG8_MMA(0, 0, At, B0); PG8_BAR; PG8_SCHED;
            PG8_LDB(B1, 0, 1); PG8_STAGE(PG8_SB(0, 0), b2, voffB);
            PG8_BAR; PG8_WAIT_L(0); PG8_MMA(0, 1, At, B1); PG8_BAR;
            PG8_LDA(At, 0, 1); PG8_STAGE(PG8_SA(0, 0), a2, voffA);
            PG8_BAR; PG8_WAIT_L(0); PG8_MMA(1, 0, At, B0); PG8_BAR; PG8_SCHED;
            PG8_STAGE(PG8_SB(0, 1), b2 + hstepB, voffB);
            PG8_WAIT_V(6); PG8_BAR; PG8_MMA(1, 1, At, B1); PG8_BAR;
            PG8_LDB(B0, 1, 0); PG8_SCHED; PG8_LDA(At, 1, 0); PG8_STAGE(PG8_SA(0, 1), a2 + hstepA, voffA);
            PG8_WAIT_L(8); PG8_BAR; PG8_WAIT_L(0); PG8_MMA(0, 0, At, B0); PG8_BAR; PG8_SCHED;
            PG8_LDB(B1, 1, 1); PG8_STAGE(PG8_SB(1, 0), b3, voffB);
            PG8_BAR; PG8_WAIT_L(0); PG8_MMA(0, 1, At, B1); PG8_BAR;
            PG8_LDA(At, 1, 1); PG8_STAGE(PG8_SA(1, 0), a3, voffA);
            PG8_BAR; PG8_WAIT_L(0); PG8_MMA(1, 0, At, B0); PG8_BAR; PG8_SCHED;
            PG8_STAGE(PG8_SB(1, 1), b3 + hstepB, voffB);
            PG8_WAIT_V(6); PG8_BAR; PG8_MMA(1, 1, At, B1); PG8_BAR;
        }
        if constexpr (Epi::REALIGN) { if (wr == 0) PG8_BAR; }
        E(acc, cur, wr, wc, fr, fq);
        if (!has_next) break;
#pragma unroll
        for (int a = 0; a < 2; ++a)
#pragma unroll
            for (int b = 0; b < 2; ++b)
#pragma unroll
                for (int m = 0; m < 4; ++m)
#pragma unroll
                    for (int n = 0; n < 2; ++n) acc[a][b][m][n] = (f32x4){0.f, 0.f, 0.f, 0.f};
        cur = nxt; cA = nA; cB = nB; ++ui;
        if constexpr (Epi::REALIGN) { if (wr == 1) PG8_BAR; }
    }
    PG8_WAIT_V(0);
    if constexpr (!Epi::REALIGN) { if (wr == 0) PG8_BAR; }
    PG8_BAR;
#undef PG8_SA
#undef PG8_SB
#undef PG8_STAGE
#undef PG8_LDA
#undef PG8_LDB
#undef PG8_MMA
#undef PG8_WAIT_V
#undef PG8_WAIT_L
#undef PG8_BAR
#undef PG8_SCHED
#undef PG8_BASEA
#undef PG8_BASEB
}
}
using pg8::Unit;
typedef const f32x4 (&AccRef)[2][2][4][2];

template <bool NORM>
struct EpiSwiglu {
    static constexpr bool PERM = true, MIDSCALE = false, REALIGN = false;
    bf16_t* hid; const float* rss; const float* shw;
    __device__ __forceinline__ void operator()(AccRef acc, const Unit& u, int wr, int wc, int fr, int fq) const {
        const int row0 = u.pm * 256 + wr * 64 + fr, col0 = u.pn * 128 + wc * 32 + 8 * fq;
        f32x4 sg0, sg1, su0, su1;
        float rsv[2][4];
        if (NORM) { const float* sp = shw + (size_t)batch_of_tile(u.pm) * NIN + u.pn * 256 + wc * 32 + 8 * fq; sg0 = *(const f32x4*)sp; sg1 = *(const f32x4*)(sp + 4); su0 = *(const f32x4*)(sp + 128); su1 = *(const f32x4*)(sp + 132);
            const float* rp = rss + row0;
#pragma unroll
            for (int ai = 0; ai < 2; ++ai)
#pragma unroll
                for (int m = 0; m < 4; ++m) rsv[ai][m] = rp[ai * 128 + m * 16];
#pragma unroll
            for (int ai = 0; ai < 2; ++ai)
#pragma unroll
                for (int m = 0; m < 4; ++m) rsv[ai][m] = rsqrtf(rsv[ai][m] * (1.0f / DM) + EPS); }
#pragma unroll
        for (int ai = 0; ai < 2; ++ai)
#pragma unroll
            for (int m = 0; m < 4; ++m) {
                const int row = row0 + ai * 128 + m * 16;
                f32x4 g0 = acc[ai][0][m][0], g1 = acc[ai][0][m][1], u0 = acc[ai][1][m][0], u1 = acc[ai][1][m][1];
                if (NORM) { const float rs = rsv[ai][m]; g0 = g0 * rs + sg0; g1 = g1 * rs + sg1; u0 = u0 * rs + su0; u1 = u1 * rs + su1; }
                u32x4 w;
                w.x = cvt_pk_bf16(silu_f(g0[0]) * u0[0], silu_f(g0[1]) * u0[1]); w.y = cvt_pk_bf16(silu_f(g0[2]) * u0[2], silu_f(g0[3]) * u0[3]);
                w.z = cvt_pk_bf16(silu_f(g1[0]) * u1[0], silu_f(g1[1]) * u1[1]); w.w = cvt_pk_bf16(silu_f(g1[2]) * u1[2], silu_f(g1[3]) * u1[3]);
                *(u32x4*)(hid + (size_t)row * DFF + col0) = w;
            }
    }
};
template <bool NORM, bool MID, bool HALFG>
struct EpiResid {
    static constexpr bool PERM = false, MIDSCALE = MID, REALIGN = true;
    static constexpr float scale = HALFG ? 0.5f : 1.0f;
    const float* srcP; const float* srcS; float* dst; const float* gate;
    bf16_t* hn; const float* gain; const float* sc; float* rss;
    const float* rsa; const float* rsb;
    __device__ __forceinline__ void midscale(f32x4 (&acc)[2][2][4][2], const Unit& u, int wr, int fr) const {
        const size_t row0 = (size_t)(u.pm * 256 + wr * 64 + fr);
        const float* pa = rsa + row0; const float* pb = rsb + row0;
#pragma unroll
        for (int ai = 0; ai < 2; ++ai)
#pragma unroll
            for (int m = 0; m < 4; ++m) {
                const float sa = __hip_atomic_load(pa + (ai * 128 + m * 16), __ATOMIC_RELAXED, __HIP_MEMORY_SCOPE_AGENT), sb = __hip_atomic_load(pb + (ai * 128 + m * 16), __ATOMIC_RELAXED, __HIP_MEMORY_SCOPE_AGENT);
                const float ra = rsqrtf(sa * (1.0f / 512) + EPS), rb = rsqrtf(sb * (1.0f / 512) + EPS), q = ra * __builtin_amdgcn_rcpf(rb);
#pragma unroll
                for (int bj = 0; bj < 2; ++bj)
#pragma unroll
                    for (int n = 0; n < 2; ++n) acc[ai][bj][m][n] *= q;
            }
    }
    __device__ __forceinline__ void operator()(f32x4 (&acc)[2][2][4][2], const Unit& u, int wr, int wc, int fr, int fq) const {
        const int row0 = u.pm * 256 + wr * 64 + fr, col0 = u.pn * 256 + wc * 32 + 4 * fq;
        const int b = batch_of_tile(u.pm);
        const float* src = (u.pm < 64 ? srcP : srcS - (size_t)MP * DM) + (size_t)row0 * DM + col0;
        float* dp = dst + (size_t)row0 * DM + col0;
        {
            f32x4 gv[2][2];
#pragma unroll
            for (int bj = 0; bj < 2; ++bj)
#pragma unroll
                for (int n = 0; n < 2; ++n) gv[bj][n] = *(const f32x4*)(gate + (size_t)b * 9216 + col0 + bj * 128 + n * 16) * scale;
            float rbv[2][4];
            if (MID) { const float* rp = rsb + row0;
#pragma unroll
                for (int ai = 0; ai < 2; ++ai)
#pragma unroll
                    for (int m = 0; m < 4; ++m) rbv[ai][m] = rp[ai * 128 + m * 16];
#pragma unroll
                for (int ai = 0; ai < 2; ++ai)
#pragma unroll
                    for (int m = 0; m < 4; ++m) rbv[ai][m] = rsqrtf(rbv[ai][m] * (1.0f / 512) + EPS); }
#pragma unroll
            for (int ai = 0; ai < 2; ++ai)
#pragma unroll
                for (int m = 0; m < 4; ++m) {
#pragma unroll
                    for (int bj = 0; bj < 2; ++bj)
#pragma unroll
                        for (int n = 0; n < 2; ++n) { if (MID) acc[ai][bj][m][n] *= gv[bj][n] * rbv[ai][m]; else acc[ai][bj][m][n] *= gv[bj][n]; }
                    asm volatile("" : "+v"(acc[ai][0][m][0]), "+v"(acc[ai][0][m][1]), "+v"(acc[ai][1][m][0]), "+v"(acc[ai][1][m][1]));
                }
        }
        f32x4 gs[2][2];
        if (NORM) {
#pragma unroll
            for (int bj = 0; bj < 2; ++bj)
#pragma unroll
                for (int n = 0; n < 2; ++n) { const int c = col0 + bj * 128 + n * 16; gs[bj][n] = *(const f32x4*)(gain + c) * (*(const f32x4*)(sc + (size_t)b * 9216 + c) + 1.0f); }
        }
        constexpr int MB = NORM ? 2 : 4;
#pragma unroll
        for (int ai = 0; ai < 2; ++ai)
#pragma unroll
            for (int m0 = 0; m0 < 4; m0 += MB) {
                f32x4 bs[MB][2][2];
#pragma unroll
                for (int mm = 0; mm < MB; ++mm)
#pragma unroll
                    for (int bj = 0; bj < 2; ++bj)
#pragma unroll
                        for (int n = 0; n < 2; ++n) bs[mm][bj][n] = *(const f32x4*)(src + (size_t)(ai * 128 + (m0 + mm) * 16) * DM + bj * 128 + n * 16);
#pragma unroll
                for (int mm = 0; mm < MB; ++mm) {
                    const int m = m0 + mm;
                    float ss = 0.f;
#pragma unroll
                    for (int bj = 0; bj < 2; ++bj)
#pragma unroll
                        for (int n = 0; n < 2; ++n) {
                            const f32x4 o = bs[mm][bj][n] + acc[ai][bj][m][n];
                            *(f32x4*)(dp + (size_t)(ai * 128 + m * 16) * DM + bj * 128 + n * 16) = o;
                            if (NORM) { ss += o[0] * o[0] + o[1] * o[1] + o[2] * o[2] + o[3] * o[3]; const f32x4 h = o * gs[bj][n]; u32x2 w; w.x = cvt_pk_bf16(h[0], h[1]); w.y = cvt_pk_bf16(h[2], h[3]);
                                *(u32x2*)(hn + (size_t)(row0 + ai * 128 + m * 16) * DM + col0 + bj * 128 + n * 16) = w; }
                        }
                    if (NORM) { ss += __shfl_xor(ss, 16); ss += __shfl_xor(ss, 32); if (fq == 0) unsafeAtomicAdd(rss + row0 + ai * 128 + m * 16, ss); }
                }
                asm volatile("" ::: "memory");
            }
    }
};
struct EpiResidFinal {
    static constexpr bool PERM = false, MIDSCALE = false, REALIGN = true;
    const float* src; float* dst; const float* gate; const float* gfin; float* rss3; unsigned* pcnt;
    __device__ __forceinline__ void operator()(f32x4 (&acc)[2][2][4][2], const Unit& u, int wr, int wc, int fr, int fq) const {
        const int row0 = u.pm * 256 + wr * 64 + fr, col0 = u.pn * 256 + wc * 32 + 4 * fq;
        const int b = batch_of_tile(u.pm);
        float* xp = dst + (size_t)row0 * DM + col0;
        {
            f32x4 gv[2][2];
#pragma unroll
            for (int bj = 0; bj < 2; ++bj)
#pragma unroll
                for (int n = 0; n < 2; ++n) gv[bj][n] = *(const f32x4*)(gate + (size_t)b * 9216 + col0 + bj * 128 + n * 16) * 0.5f;
#pragma unroll
            for (int ai = 0; ai < 2; ++ai) {
                f32x4 bs[4][2][2];
#pragma unroll
                for (int mm = 0; mm < 4; ++mm)
#pragma unroll
                    for (int bj = 0; bj < 2; ++bj)
#pragma unroll
                        for (int n = 0; n < 2; ++n) bs[mm][bj][n] = *(const f32x4*)(xp + (size_t)(ai * 128 + mm * 16) * DM + bj * 128 + n * 16);
#pragma unroll
                for (int mm = 0; mm < 4; ++mm) {
#pragma unroll
                    for (int bj = 0; bj < 2; ++bj)
#pragma unroll
                        for (int n = 0; n < 2; ++n) acc[ai][bj][mm][n] = bs[mm][bj][n] + gv[bj][n] * acc[ai][bj][mm][n];
                    asm volatile("" : "+v"(acc[ai][0][mm][0]), "+v"(acc[ai][0][mm][1]), "+v"(acc[ai][1][mm][0]), "+v"(acc[ai][1][mm][1]));
                }
                asm volatile("" ::: "memory");
            }
        }
        float* rp = rss3 + row0;
        float keep = 0.f;
#pragma unroll
        for (int ai = 0; ai < 2; ++ai)
#pragma unroll
            for (int m = 0; m < 4; ++m) { float ss = 0.f;
#pragma unroll
                for (int bj = 0; bj < 2; ++bj)
#pragma unroll
                    for (int n = 0; n < 2; ++n) { const f32x4 o = acc[ai][bj][m][n]; ss += o[0] * o[0] + o[1] * o[1] + o[2] * o[2] + o[3] * o[3]; }
                ss += __shfl_xor(ss, 16); ss += __shfl_xor(ss, 32);
                if (fq == 0) keep += __hip_atomic_fetch_add(rp + (ai * 128 + m * 16), ss, __ATOMIC_RELAXED, __HIP_MEMORY_SCOPE_AGENT); }
        asm volatile("s_waitcnt vmcnt(0)" :: "v"(keep) : "memory");
        unsigned* cp = pcnt + (size_t)(u.pm * 2 + wr) * 64;
        if ((threadIdx.x & 63) == 0) __hip_atomic_fetch_add(cp, 1u, __ATOMIC_RELAXED, __HIP_MEMORY_SCOPE_AGENT);
        { unsigned spins = 0;
          while ((unsigned)__builtin_amdgcn_readfirstlane(__hip_atomic_load(cp, __ATOMIC_RELAXED, __HIP_MEMORY_SCOPE_AGENT)) < 16u) { __builtin_amdgcn_s_sleep(1); if (++spins > (1u << 17)) break; } }
        asm volatile("" ::: "memory");
        float rsv[2][4];
#pragma unroll
        for (int ai = 0; ai < 2; ++ai)
#pragma unroll
            for (int m = 0; m < 4; ++m) rsv[ai][m] = __hip_atomic_load(rp + (ai * 128 + m * 16), __ATOMIC_RELAXED, __HIP_MEMORY_SCOPE_AGENT);
        f32x4 gf[2][2];
#pragma unroll
        for (int bj = 0; bj < 2; ++bj)
#pragma unroll
            for (int n = 0; n < 2; ++n) gf[bj][n] = *(const f32x4*)(gfin + col0 + bj * 128 + n * 16);
#pragma unroll
        for (int ai = 0; ai < 2; ++ai)
#pragma unroll
            for (int m = 0; m < 4; ++m) { const float rs = rsqrtf(rsv[ai][m] * (1.0f / DM) + EPS);
#pragma unroll
                for (int bj = 0; bj < 2; ++bj)
#pragma unroll
                    for (int n = 0; n < 2; ++n) *(f32x4*)(xp + (size_t)(ai * 128 + m * 16) * DM + bj * 128 + n * 16) = acc[ai][bj][m][n] * rs * gf[bj][n]; }
    }
};
struct EpiMixIn {
    static constexpr bool PERM = true, MIDSCALE = false, REALIGN = false;
    bf16_t* ug; bf16_t* ugm; bf16_t* vg; const float* rss; const float* shw;
    __device__ __forceinline__ void operator()(AccRef acc, const Unit& u, int wr, int wc, int fr, int fq) const {
        const int row0 = u.pm * 256 + wr * 64 + fr, colt = wc * 32 + 8 * fq;
        const float* sp = shw + (size_t)batch_of_tile(u.pm) * NMIX + u.pn * 256 + colt;
        f32x4 sv[2][2];
#pragma unroll
        for (int bj = 0; bj < 2; ++bj)
#pragma unroll
            for (int n = 0; n < 2; ++n) sv[bj][n] = *(const f32x4*)(sp + bj * 128 + 4 * n);
        float rsv[2][4];
        { const float* rp = rss + row0;
#pragma unroll
            for (int ai = 0; ai < 2; ++ai)
#pragma unroll
                for (int m = 0; m < 4; ++m) rsv[ai][m] = rp[ai * 128 + m * 16];
#pragma unroll
            for (int ai = 0; ai < 2; ++ai)
#pragma unroll
                for (int m = 0; m < 4; ++m) rsv[ai][m] = rsqrtf(rsv[ai][m] * (1.0f / DM) + EPS); }
        if (u.pn < 2) {
#pragma unroll
            for (int ai = 0; ai < 2; ++ai)
#pragma unroll
                for (int m = 0; m < 4; ++m) { const int row = row0 + ai * 128 + m * 16; const float rs = rsv[ai][m];
#pragma unroll
                    for (int bj = 0; bj < 2; ++bj) { const int c = u.pn * 256 + bj * 128 + colt; const f32x4 v0 = acc[ai][bj][m][0] * rs + sv[bj][0], v1 = acc[ai][bj][m][1] * rs + sv[bj][1];
                        u32x4 w; w.x = cvt_pk_bf16(v0[0], v0[1]); w.y = cvt_pk_bf16(v0[2], v0[3]); w.z = cvt_pk_bf16(v1[0], v1[1]); w.w = cvt_pk_bf16(v1[2], v1[3]);
                        *(u32x4*)(ug + ((size_t)(c >> 4) * NCHK + (row >> 5)) * KS2 + (row & 31) * 16 + (c & 15)) = w; } }
        } else {
            bf16_t* o = (u.pn < 4 ? ugm : vg) + (u.pn & 1) * 256 + colt;
#pragma unroll
            for (int ai = 0; ai < 2; ++ai)
#pragma unroll
                for (int m = 0; m < 4; ++m) { const int row = row0 + ai * 128 + m * 16; const float rs = rsv[ai][m];
#pragma unroll
                    for (int bj = 0; bj < 2; ++bj) { const f32x4 v0 = acc[ai][bj][m][0] * rs + sv[bj][0], v1 = acc[ai][bj][m][1] * rs + sv[bj][1];
                        u32x4 w; w.x = cvt_pk_bf16(gelu_f(v0[0]), gelu_f(v0[1])); w.y = cvt_pk_bf16(gelu_f(v0[2]), gelu_f(v0[3])); w.z = cvt_pk_bf16(gelu_f(v1[0]), gelu_f(v1[1])); w.w = cvt_pk_bf16(gelu_f(v1[2]), gelu_f(v1[3]));
                        *(u32x4*)(o + (size_t)row * 512 + bj * 128) = w; } }
        }
    }
};
struct EpiS1 {
    static constexpr bool PERM = false, MIDSCALE = false, REALIGN = false;
    float* sloc;
    __device__ __forceinline__ void operator()(AccRef acc, const Unit& u, int wr, int wc, int fr, int fq) const {
        const int row0 = u.pm * 256 + wr * 64 + fr, col0 = wc * 32 + 4 * fq;
#pragma unroll
        for (int ai = 0; ai < 2; ++ai)
#pragma unroll
            for (int m = 0; m < 4; ++m) { float* rp = sloc + ((size_t)u.g * NCHK + row0 + ai * 128 + m * 16) * 256 + col0;
#pragma unroll
                for (int bj = 0; bj < 2; ++bj)
#pragma unroll
                    for (int n = 0; n < 2; ++n) *(f32x4*)(rp + bj * 128 + n * 16) = acc[ai][bj][m][n]; }
    }
};
struct EpiS2 {
    static constexpr bool PERM = true, MIDSCALE = false, REALIGN = false;
    bf16_t* y;
    __device__ __forceinline__ void operator()(AccRef acc, const Unit& u, int wr, int wc, int fr, int fq) const {
        const int row0 = u.pm * 256 + wr * 64 + fr, colt = u.pn * 256 + wc * 32 + 8 * fq;
#pragma unroll
        for (int ai = 0; ai < 2; ++ai)
#pragma unroll
            for (int m = 0; m < 4; ++m) { const int chunk = row0 + ai * 128 + m * 16;
#pragma unroll
                for (int bj = 0; bj < 2; ++bj) { const int c = colt + bj * 128; const f32x4 v0 = acc[ai][bj][m][0], v1 = acc[ai][bj][m][1];
                    u32x4 w; w.x = cvt_pk_bf16(gelu_f(v0[0]), gelu_f(v0[1])); w.y = cvt_pk_bf16(gelu_f(v0[2]), gelu_f(v0[3])); w.z = cvt_pk_bf16(gelu_f(v1[0]), gelu_f(v1[1])); w.w = cvt_pk_bf16(gelu_f(v1[2]), gelu_f(v1[3]));
                    *(u32x4*)(y + ((size_t)u.g * NCHK + chunk) * 512 + c) = w; } }
    }
};
struct EpiGlu {
    static constexpr bool PERM = true, MIDSCALE = false, REALIGN = true;
    const bf16_t* y; bf16_t* h; const float* gain; float* rssa;
    __device__ __forceinline__ void operator()(AccRef acc, const Unit& u, int wr, int wc, int fr, int fq) const {
        const int row0 = u.pm * 256 + wr * 64 + fr, col0 = u.pn * 256 + wc * 32 + 8 * fq;
        f32x4 gn[2][2];
#pragma unroll
        for (int bj = 0; bj < 2; ++bj)
#pragma unroll
            for (int n = 0; n < 2; ++n) gn[bj][n] = *(const f32x4*)(gain + col0 + bj * 128 + 4 * n);
        const bf16_t* yb = y + ((size_t)(col0 >> 4) * NCHK + (row0 >> 5)) * 512 + (row0 & 31) * 16 + (col0 & 15);
#pragma unroll
        for (int ai = 0; ai < 2; ++ai) {
            u32x4 yv[4][2];
#pragma unroll
            for (int m = 0; m < 4; ++m)
#pragma unroll
                for (int bj = 0; bj < 2; ++bj) yv[m][bj] = *(const u32x4*)(yb + (size_t)bj * 8 * NCHK * 512 + (ai * 4 + (m >> 1)) * 512 + (m & 1) * 256);
#pragma unroll
            for (int m = 0; m < 4; ++m) { const int row = row0 + ai * 128 + m * 16; float ss = 0.f;
#pragma unroll
                for (int bj = 0; bj < 2; ++bj) { const u32x4 q = yv[m][bj]; const f32x4 v0 = acc[ai][bj][m][0], v1 = acc[ai][bj][m][1];
                    f32x4 a, b; a[0] = bflo(q.x) * sigmoid_f(v0[0]); a[1] = bfhi(q.x) * sigmoid_f(v0[1]); a[2] = bflo(q.y) * sigmoid_f(v0[2]); a[3] = bfhi(q.y) * sigmoid_f(v0[3]);
                    b[0] = bflo(q.z) * sigmoid_f(v1[0]); b[1] = bfhi(q.z) * sigmoid_f(v1[1]); b[2] = bflo(q.w) * sigmoid_f(v1[2]); b[3] = bfhi(q.w) * sigmoid_f(v1[3]);
                    ss += a[0] * a[0] + a[1] * a[1] + a[2] * a[2] + a[3] * a[3] + b[0] * b[0] + b[1] * b[1] + b[2] * b[2] + b[3] * b[3];
                    a *= gn[bj][0]; b *= gn[bj][1];
                    u32x4 w; w.x = cvt_pk_bf16(a[0], a[1]); w.y = cvt_pk_bf16(a[2], a[3]); w.z = cvt_pk_bf16(b[0], b[1]); w.w = cvt_pk_bf16(b[2], b[3]);
                    *(u32x4*)(h + (size_t)row * DM + col0 + bj * 128) = w; }
                ss += __shfl_xor(ss, 16); ss += __shfl_xor(ss, 32); if (fq == 0) unsafeAtomicAdd(rssa + row, ss); }
            asm volatile("" ::: "memory");
        }
    }
};
struct EpiSpatial {
    static constexpr bool PERM = true, MIDSCALE = false, REALIGN = true;
    const bf16_t* ugm; const float* bsp; bf16_t* h; const float* gain; float* rssb;
    __device__ __forceinline__ void operator()(AccRef acc, const Unit& u, int wr, int wc, int fr, int fq) const {
        const int row0 = u.pm * 256 + wr * 64 + fr, col0 = u.pn * 256 + wc * 32 + 8 * fq, cc = wc * 32 + 8 * fq;
        const int q0 = row0 & 127;
        const bf16_t* up = ugm + ((size_t)(u.pn * 2) * 128 + q0) * 512 + cc;
        float bqv[2][4]; f32x4 gg[2][2];
#pragma unroll
        for (int ai = 0; ai < 2; ++ai) { gg[ai][0] = *(const f32x4*)(gain + (u.pm * 2 + ai) * 128 + cc); gg[ai][1] = *(const f32x4*)(gain + (u.pm * 2 + ai) * 128 + cc + 4);
#pragma unroll
            for (int m = 0; m < 4; ++m) bqv[ai][m] = bsp[(u.pm * 2 + ai) * 128 + q0 + m * 16]; }
#pragma unroll
        for (int ai = 0; ai < 2; ++ai) {
            const int hh = u.pm * 2 + ai;
            const f32x4 g0 = gg[ai][0], g1 = gg[ai][1];
            u32x4 uv[4][2];
#pragma unroll
            for (int m = 0; m < 4; ++m)
#pragma unroll
                for (int bj = 0; bj < 2; ++bj) uv[m][bj] = *(const u32x4*)(up + (size_t)(bj * 128 + m * 16) * 512 + hh * 128);
#pragma unroll
            for (int m = 0; m < 4; ++m) { const int q = q0 + m * 16; const float bq = bqv[ai][m];
#pragma unroll
                for (int bj = 0; bj < 2; ++bj) { const size_t tok = (size_t)(u.pn * 2 + bj) * 128 + q;
                    const u32x4 w0 = uv[m][bj]; const f32x4 v0 = acc[ai][bj][m][0], v1 = acc[ai][bj][m][1];
                    f32x4 a, b; a[0] = bflo(w0.x) * (v0[0] + bq); a[1] = bfhi(w0.x) * (v0[1] + bq); a[2] = bflo(w0.y) * (v0[2] + bq); a[3] = bfhi(w0.y) * (v0[3] + bq);
                    b[0] = bflo(w0.z) * (v1[0] + bq); b[1] = bfhi(w0.z) * (v1[1] + bq); b[2] = bflo(w0.w) * (v1[2] + bq); b[3] = bfhi(w0.w) * (v1[3] + bq);
                    float ss = a[0] * a[0] + a[1] * a[1] + a[2] * a[2] + a[3] * a[3] + b[0] * b[0] + b[1] * b[1] + b[2] * b[2] + b[3] * b[3];
                    a *= g0; b *= g1;
                    u32x4 w; w.x = cvt_pk_bf16(a[0], a[1]); w.y = cvt_pk_bf16(a[2], a[3]); w.z = cvt_pk_bf16(b[0], b[1]); w.w = cvt_pk_bf16(b[2], b[3]);
                    *(u32x4*)(h + tok * DM + 512 + hh * 128 + cc) = w;
                    ss += __shfl_xor(ss, 16); ss += __shfl_xor(ss, 32); if (fq == 0) unsafeAtomicAdd(rssb + tok, ss); } }
            asm volatile("" ::: "memory");
        }
    }
};

__device__ __forceinline__ void transpose_job(LAS unsigned char* lds, const float* src, int Kd, int Nd, bf16_t* dst, int mode) {
    LAS bf16_t* T = (LAS bf16_t*)lds;
    const int tid = threadIdx.x, nkt = Kd / 64, nnt = Nd / 64, ntile = nkt * nnt, G = gridDim.x;
    for (int it = blockIdx.x; it < ntile; it += 2 * G) {
        const int it2 = it + G; const bool has2 = it2 < ntile; const int itb = has2 ? it2 : it;
        const int k0a = (it % nkt) * 64, n0a = (it / nkt) * 64, k0b = (itb % nkt) * 64, n0b = (itb / nkt) * 64;
        int nda = n0a, ndb = n0b;
        if (mode == 1) { const int ja = n0a < DFF ? n0a : n0a - DFF; nda = (ja >> 7) * 256 + (ja & 127) + (n0a < DFF ? 0 : 128); const int jb = n0b < DFF ? n0b : n0b - DFF; ndb = (jb >> 7) * 256 + (jb & 127) + (n0b < DFF ? 0 : 128); }
        float va[8], vb[8];
#pragma unroll
        for (int i = 0; i < 8; ++i) { const int e = tid + i * 512, kl = e >> 6, nl = e & 63; va[i] = src[(size_t)(k0a + kl) * Nd + n0a + nl]; vb[i] = src[(size_t)(k0b + kl) * Nd + n0b + nl]; }
        __syncthreads();
#pragma unroll
        for (int i = 0; i < 8; ++i) { const int e = tid + i * 512, kl = e >> 6, nl = e & 63; T[nl * 66 + kl] = f2bf(va[i]); T[64 * 66 + nl * 66 + kl] = f2bf(vb[i]); }
        __syncthreads();
#pragma unroll
        for (int i = 0; i < 4; ++i) { const int e = tid + i * 512, nl = e >> 5, kp = e & 31;
            *(unsigned*)(dst + (size_t)(nda + nl) * Kd + k0a + 2 * kp) = *(const LAS unsigned*)(T + nl * 66 + 2 * kp);
            if (has2) *(unsigned*)(dst + (size_t)(ndb + nl) * Kd + k0b + 2 * kp) = *(const LAS unsigned*)(T + 64 * 66 + nl * 66 + 2 * kp); }
    }
    __syncthreads();
}
__device__ __forceinline__ void s5_pow(float lre, float lim, double dt, int tau, double& er, double& ei) {
    const double m = exp((double)lre * dt * (double)tau), a = (double)lim * dt * (double)tau; double s, c; sincos(a, &s, &c); er = m * c; ei = m * s;
}
__device__ __forceinline__ void s5_f(float lre, float lim, double dt, double& fr, double& fi) {
    double ar, ai; s5_pow(lre, lim, dt, 1, ar, ai); const double nr = ar - 1.0, ni = ai, lr = (double)lre, li = (double)lim, den = lr * lr + li * li;
    fr = (nr * lr + ni * li) / den; fi = (ni * lr - nr * li) / den;
}

__device__ __forceinline__ void phase0(const P& p, LAS unsigned char* lds) {
    const int tid = threadIdx.x, G = gridDim.x, bid = blockIdx.x;
    unsigned char* ws = p.ws;
    {
        LAS float* S = (LAS float*)lds;
        float* MOD = (float*)(ws + WS_MOD);
        const float* wada = p.in[4]; const float* bada = p.in[5];
        for (int it = bid; it < 576; it += G) {
            const int cb = it % 36, kc = it / 36;
            __syncthreads();
            for (int e = tid; e < 1024; e += 512) { const int b = e >> 6, k = e & 63; const float* c = b < 8 ? p.in[2] + b * 1024 : p.in[3] + (b - 8) * 1024; const float v = c[kc * 64 + k]; S[e] = silu_f(v); }
            __syncthreads();
            const int col = cb * 256 + (tid & 255), kh = tid >> 8;
            float acc[16];
#pragma unroll
            for (int b = 0; b < 16; ++b) acc[b] = 0.f;
#pragma unroll 8
            for (int kk = 0; kk < 32; ++kk) { const int k = kh * 32 + kk; const float w = wada[(size_t)(kc * 64 + k) * 9216 + col];
#pragma unroll
                for (int b = 0; b < 16; ++b) acc[b] += S[b * 64 + k] * w; }
            if (kc == 0 && kh == 0) { const float bb = bada[col];
#pragma unroll
                for (int b = 0; b < 16; ++b) acc[b] += bb; }
#pragma unroll
            for (int b = 0; b < 16; ++b) unsafeAtomicAdd(MOD + b * 9216 + col, acc[b]);
        }
        __syncthreads();
    }
    transpose_job(lds, p.in[7], DM, NIN, (bf16_t*)(ws + WS_WIN1), 1);
    transpose_job(lds, p.in[35], DM, NIN, (bf16_t*)(ws + WS_WIN2), 1);
    transpose_job(lds, p.in[8], DFF, DM, (bf16_t*)(ws + WS_WOUT1), 0);
    transpose_job(lds, p.in[36], DFF, DM, (bf16_t*)(ws + WS_WOUT2), 0);
    transpose_job(lds, p.in[10], DM, NMIX, (bf16_t*)(ws + WS_WMIXIN), 0);
    transpose_job(lds, p.in[26], 512, 512, (bf16_t*)(ws + WS_WGLU), 0);
    transpose_job(lds, p.in[33], DM, DM, (bf16_t*)(ws + WS_WMIXOUT), 0);
    {
        bf16_t* wbd = (bf16_t*)(ws + WS_WBD); const float* wsp = p.in[29];
        for (int i = bid * 512 + tid; i < 512 * 64; i += G * 512) {
            const int kg = i & 63, row = i >> 6, h = row >> 7, q = row & 127, col0 = kg * 8, hp = col0 >> 7, k0 = col0 & 127;
            u32x4 w = (u32x4){0u, 0u, 0u, 0u};
            if (h == hp) { const float* s = wsp + ((size_t)h * 128 + q) * 128 + k0; const f32x4 a = *(const f32x4*)s, b = *(const f32x4*)(s + 4);
                w.x = cvt_pk_bf16(a[0], a[1]); w.y = cvt_pk_bf16(a[2], a[3]); w.z = cvt_pk_bf16(b[0], b[1]); w.w = cvt_pk_bf16(b[2], b[3]); }
            *(u32x4*)(wbd + (size_t)row * 512 + col0) = w;
        }
    }
    {
        LAS float* EBr = (LAS float*)lds; LAS float* EBi = EBr + 1024;
        float* klag = (float*)(ws + WS_KLAG);
        for (int it = bid; it < NGRP * 63; it += G) {
            const int g = it / 63, l = it % 63;
            float accv = 0.f;
            for (int dir = 0; dir < 2; ++dir) {
                if ((dir == 0 && l > 31) || (dir == 1 && l < 31)) continue;
                const int tau = dir == 0 ? 31 - l : l - 31; const int o = dir * 7;
                const float* lre = p.in[11 + o]; const float* lim = p.in[12 + o]; const float* lst = p.in[13 + o];
                const float* bre = p.in[14 + o]; const float* bim = p.in[15 + o]; const float* cre = p.in[16 + o]; const float* cim = p.in[17 + o];
                const double dt = exp((double)lst[g]);
                __syncthreads();
                for (int idx = tid; idx < 1024; idx += 512) { const int pp = idx >> 4, hp = idx & 15; const float a = lre[g * 64 + pp], b = lim[g * 64 + pp];
                    double er, ei, fr, fi; s5_pow(a, b, dt, tau, er, ei); s5_f(a, b, dt, fr, fi);
                    const double gr = er * fr - ei * fi, gi = er * fi + ei * fr; const double br = bre[(g * 64 + pp) * 16 + hp], bi = bim[(g * 64 + pp) * 16 + hp];
                    EBr[idx] = (float)(gr * br - gi * bi); EBi[idx] = (float)(gr * bi + gi * br); }
                __syncthreads();
                if (tid < 256) { const int h = tid >> 4, hp = tid & 15; const float* cr = cre + (g * 16 + h) * 64; const float* ci = cim + (g * 16 + h) * 64; float s = 0.f;
                    for (int pp = 0; pp < 64; ++pp) s += cr[pp] * EBr[pp * 16 + hp] - ci[pp] * EBi[pp * 16 + hp];
                    accv += s; }
            }
            if (tid < 256) { const int h = tid >> 4, hp = tid & 15; if (l == 31 && h == hp) accv += p.in[25][g * 16 + h]; klag[((size_t)g * 63 + l) * 256 + tid] = accv; }
        }
        __syncthreads();
    }
    {
        bf16_t* w1s = (bf16_t*)(ws + WS_W1S); bf16_t* w2s = (bf16_t*)(ws + WS_W2S);
        for (int it = bid; it < NGRP * 2 * 32; it += G) {
            const int t = it & 31, dir = (it >> 5) & 1, g = it >> 6; const int o = dir * 7;
            const int pp = tid & 63, hh = tid >> 6;
            const float a = p.in[11 + o][g * 64 + pp], b = p.in[12 + o][g * 64 + pp]; const double dt = exp((double)p.in[13 + o][g]);
            double e1r, e1i, e2r, e2i, fr, fi;
            s5_pow(a, b, dt, dir == 0 ? 31 - t : t, e1r, e1i); s5_pow(a, b, dt, dir == 0 ? t + 1 : 32 - t, e2r, e2i); s5_f(a, b, dt, fr, fi);
            const double gr = e1r * fr - e1i * fi, gi = e1r * fi + e1i * fr;
#pragma unroll
            for (int j = 0; j < 2; ++j) { const int h = 2 * hh + j;
                const double br = p.in[14 + o][(g * 64 + pp) * 16 + h], bi = p.in[15 + o][(g * 64 + pp) * 16 + h];
                w1s[((size_t)g * 256 + dir * 128 + pp) * 512 + t * 16 + h] = f2bf((float)(gr * br - gi * bi));
                w1s[((size_t)g * 256 + dir * 128 + 64 + pp) * 512 + t * 16 + h] = f2bf((float)(gr * bi + gi * br));
                const double cr = p.in[16 + o][(g * 16 + h) * 64 + pp], ci = p.in[17 + o][(g * 16 + h) * 64 + pp];
                w2s[((size_t)g * 512 + t * 16 + h) * KS2 + 512 + dir * 128 + pp] = f2bf((float)(cr * e2r - ci * e2i));
                w2s[((size_t)g * 512 + t * 16 + h) * KS2 + 512 + dir * 128 + 64 + pp] = f2bf((float)(-(cr * e2i + ci * e2r))); }
        }
    }
}

__device__ __forceinline__ void pass_modnorm_in(const P& p, const float* gain, int shidx) {
    const int lane = threadIdx.x & 63, wave = threadIdx.x >> 6;
    const float* MOD = (const float*)(p.ws + WS_MOD); bf16_t* H = (bf16_t*)(p.ws + WS_H);
    const int stride = gridDim.x * 8;
    for (int row = blockIdx.x * 8 + wave; row < MT; row += 4 * stride) {
        f32x4 v[4][4]; float ss[4]; int rr[4];
#pragma unroll
        for (int q = 0; q < 4; ++q) { const int r = row + q * stride; rr[q] = r < MT ? r : row; const float* s0 = rr[q] < MP ? p.in[0] + (size_t)rr[q] * DM : p.in[1] + (size_t)(rr[q] - MP) * DM;
#pragma unroll
            for (int i = 0; i < 4; ++i) v[q][i] = *(const f32x4*)(s0 + i * 256 + lane * 4); }
#pragma unroll
        for (int q = 0; q < 4; ++q) { float a = 0.f;
#pragma unroll
            for (int i = 0; i < 4; ++i) a += v[q][i][0] * v[q][i][0] + v[q][i][1] * v[q][i][1] + v[q][i][2] * v[q][i][2] + v[q][i][3] * v[q][i][3];
            ss[q] = rsqrtf(wave_sum(a) * (1.0f / DM) + EPS); }
#pragma unroll
        for (int i = 0; i < 4; ++i) { const int c = i * 256 + lane * 4; const f32x4 g4 = *(const f32x4*)(gain + c);
#pragma unroll
            for (int q = 0; q < 4; ++q) { if (row + q * stride < MT) { const float* sh = MOD + (size_t)batch_of_row(rr[q]) * 9216 + shidx * 1024;
                const f32x4 s4 = *(const f32x4*)(sh + 1024 + c), h4 = *(const f32x4*)(sh + c); const f32x4 o = v[q][i] * ss[q] * g4 * (s4 + 1.0f) + h4;
                u32x2 w; w.x = cvt_pk_bf16(o[0], o[1]); w.y = cvt_pk_bf16(o[2], o[3]); *(u32x2*)(H + (size_t)rr[q] * DM + c) = w; } } }
    }
}
__device__ __forceinline__ void pass_shw(const P& p, LAS unsigned char* lds, const bf16_t* Wt, int N, int shidx, float* out) {
    const int tid = threadIdx.x, lane = tid & 63, wave = tid >> 6;
    LAS float* S = (LAS float*)lds;
    const float* MOD = (const float*)(p.ws + WS_MOD);
    __syncthreads();
    for (int e = tid; e < 16 * 256; e += 512) { const int b = e >> 8, k4 = e & 255; *(LAS f32x4*)(S + b * 1024 + k4 * 4) = *(const f32x4*)(MOD + (size_t)b * 9216 + shidx * 1024 + k4 * 4); }
    __syncthreads();
    for (int n = blockIdx.x * 8 + wave; n < N; n += gridDim.x * 8) {
        float w[16];
#pragma unroll
        for (int j = 0; j < 4; ++j) { const u32x2 q = *(const u32x2*)(Wt + (size_t)n * DM + j * 256 + lane * 4); w[j * 4] = bflo(q.x); w[j * 4 + 1] = bfhi(q.x); w[j * 4 + 2] = bflo(q.y); w[j * 4 + 3] = bfhi(q.y); }
        float mine = 0.f;
#pragma unroll 1
        for (int b = 0; b < 16; ++b) { float a = 0.f;
#pragma unroll
            for (int j = 0; j < 4; ++j) { const f32x4 s4 = *(const LAS f32x4*)(S + b * 1024 + j * 256 + lane * 4); a += w[j * 4] * s4[0] + w[j * 4 + 1] * s4[1] + w[j * 4 + 2] * s4[2] + w[j * 4 + 3] * s4[3]; }
            a = wave_sum(a); if (lane == b) mine = a; }
        if (lane < 16) out[(size_t)lane * N + n] = mine;
    }
    __syncthreads();
}
__device__ __forceinline__ void pass_final(const P& p) {
    const int lane = threadIdx.x & 63, wave = threadIdx.x >> 6; const float* gain = p.in[37];
    for (int row = blockIdx.x * 8 + wave; row < MT; row += gridDim.x * 8) {
        float* src = p.out + (size_t)row * DM; f32x4 v[4]; float ss = 0.f;
#pragma unroll
        for (int i = 0; i < 4; ++i) { v[i] = *(const f32x4*)(src + i * 256 + lane * 4); ss += v[i][0] * v[i][0] + v[i][1] * v[i][1] + v[i][2] * v[i][2] + v[i][3] * v[i][3]; }
        ss = wave_sum(ss); const float rstd = rsqrtf(ss * (1.0f / DM) + EPS);
#pragma unroll
        for (int i = 0; i < 4; ++i) { const int c = i * 256 + lane * 4; *(f32x4*)(src + c) = v[i] * rstd * *(const f32x4*)(gain + c); }
    }
}
__device__ __forceinline__ void fill_kmat(const P& p) {
    const float* klag = (const float*)(p.ws + WS_KLAG); bf16_t* w2s = (bf16_t*)(p.ws + WS_W2S);
    for (int i = blockIdx.x * 512 + threadIdx.x; i < NGRP * 512 * 64; i += gridDim.x * 512) {
        const int kg = i & 63, n = (i >> 6) & 511, g = i >> 15, t = n >> 4, h = n & 15, s = kg >> 1, hp0 = (kg & 1) * 8, l = s - t + 31;
        const float* src = klag + ((size_t)g * 63 + l) * 256 + h * 16 + hp0; const f32x4 a = *(const f32x4*)src, b = *(const f32x4*)(src + 4);
        u32x4 w; w.x = cvt_pk_bf16(a[0], a[1]); w.y = cvt_pk_bf16(a[2], a[3]); w.z = cvt_pk_bf16(b[0], b[1]); w.w = cvt_pk_bf16(b[2], b[3]);
        *(u32x4*)(w2s + ((size_t)g * 512 + n) * KS2 + s * 16 + hp0) = w;
    }
}
__device__ __forceinline__ void pass_ln_transpose(const P& p, LAS unsigned char* lds) {
    const int tid = threadIdx.x;
    LAS float* ST = (LAS float*)lds;
    LAS bf16_t* T = (LAS bf16_t*)(lds + 1024);
    const bf16_t* vg = (const bf16_t*)(p.ws + WS_VG); bf16_t* vt = (bf16_t*)(p.ws + WS_VT);
    const float* lg = p.in[27]; const float* lb = p.in[28];
    for (int bn = blockIdx.x; bn < MT / 128; bn += gridDim.x) {
        __syncthreads();
        {
            const int k = tid >> 2, pp = tid & 3; const bf16_t* rp = vg + ((size_t)bn * 128 + k) * 512 + pp * 8;
            u32x4 a[16];
#pragma unroll
            for (int j = 0; j < 16; ++j) a[j] = *(const u32x4*)(rp + j * 32);
            float s = 0.f, q = 0.f;
#pragma unroll
            for (int j = 0; j < 16; ++j) { const float x0 = bflo(a[j].x), x1 = bfhi(a[j].x), x2 = bflo(a[j].y), x3 = bfhi(a[j].y), x4 = bflo(a[j].z), x5 = bfhi(a[j].z), x6 = bflo(a[j].w), x7 = bfhi(a[j].w);
                s += ((x0 + x1) + (x2 + x3)) + ((x4 + x5) + (x6 + x7)); q += ((x0 * x0 + x1 * x1) + (x2 * x2 + x3 * x3)) + ((x4 * x4 + x5 * x5) + (x6 * x6 + x7 * x7)); }
            s += __shfl_xor(s, 1); q += __shfl_xor(q, 1); s += __shfl_xor(s, 2); q += __shfl_xor(q, 2);
            const float mu = s * (1.0f / 512), var = fmaxf(q * (1.0f / 512) - mu * mu, 0.f);
            if (pp == 0) { ST[k * 2] = mu; ST[k * 2 + 1] = rsqrtf(var + EPS); }
        }
        __syncthreads();
        for (int h = 0; h < 4; ++h) {
#pragma unroll
            for (int i = 0; i < 4; ++i) { const int idx = tid + i * 512, k = idx >> 4, cg = idx & 15, c0 = cg * 8, kx = k ^ (cg << 3);
                const u32x4 a = *(const u32x4*)(vg + ((size_t)bn * 128 + k) * 512 + h * 128 + c0); const float mu = ST[k * 2], rs = ST[k * 2 + 1];
                const float x[8] = {bflo(a.x), bfhi(a.x), bflo(a.y), bfhi(a.y), bflo(a.z), bfhi(a.z), bflo(a.w), bfhi(a.w)};
                const f32x4 g0 = *(const f32x4*)(lg + h * 128 + c0), g1 = *(const f32x4*)(lg + h * 128 + c0 + 4), b0 = *(const f32x4*)(lb + h * 128 + c0), b1 = *(const f32x4*)(lb + h * 128 + c0 + 4);
#pragma unroll
                for (int j = 0; j < 4; ++j) { T[(c0 + j) * 136 + kx] = f2bf((x[j] - mu) * rs * g0[j] + b0[j]); T[(c0 + 4 + j) * 136 + kx] = f2bf((x[4 + j] - mu) * rs * g1[j] + b1[j]); } }
            __syncthreads();
#pragma unroll
            for (int i = 0; i < 4; ++i) { const int idx = tid + i * 512, c = idx >> 4, kg = idx & 15;
                *(u32x4*)(vt + (((size_t)bn * 128 + c) * 4 + h) * 128 + kg * 8) = *(const LAS u32x4*)(T + c * 136 + ((kg ^ ((c >> 3) & 15)) << 3)); }
            __syncthreads();
        }
    }
}
__device__ __forceinline__ void pass_chunk_scan(const P& p) {
    const float* sloc = (const float*)(p.ws + WS_SLOC); bf16_t* ug = (bf16_t*)(p.ws + WS_UG);
    for (int T = blockIdx.x * 512 + threadIdx.x; T < 16 * NGRP * 128; T += gridDim.x * 512) {
        const int j = T & 127, dir = j >> 6, pp = j & 63, g = (T >> 7) & 31, b = T >> 12;
        const int cb = b < 8 ? b * 64 : 512 + (b - 8) * 256, nc = b < 8 ? 64 : 256; const int o = dir * 7;
        const double dt = exp((double)p.in[13 + o][g]); double er, ei; s5_pow(p.in[11 + o][g * 64 + pp], p.in[12 + o][g * 64 + pp], dt, TCH, er, ei);
        const float ar = (float)er, ai = (float)ei;
        const float* lp = sloc + ((size_t)g * NCHK + cb) * 256 + dir * 128 + pp;
        bf16_t* up = ug + ((size_t)g * NCHK + cb) * KS2 + 512 + dir * 128 + pp;
        float sr = 0.f, si = 0.f;
        for (int c0 = 0; c0 < nc; c0 += 8) {
            float lr[8], li[8];
#pragma unroll
            for (int q = 0; q < 8; ++q) { const int c = dir == 0 ? c0 + q : nc - 1 - (c0 + q); lr[q] = lp[(size_t)c * 256]; li[q] = lp[(size_t)c * 256 + 64]; }
#pragma unroll
            for (int q = 0; q < 8; ++q) { const int c = dir == 0 ? c0 + q : nc - 1 - (c0 + q);
                up[(size_t)c * KS2] = f2bf(sr); up[(size_t)c * KS2 + 64] = f2bf(si);
                const float nr = ar * sr - ai * si + lr[q], ni = ar * si + ai * sr + li[q]; sr = nr; si = ni; }
        }
    }
}


#define XB_TMO      128
#define XB_XCNT(j)  (256  + 64 * (j))
#define XB_XSUB(j)  (1280 + 64 * (j))
#define XB_XGEN(j)  (2304 + 64 * (j))
#define XB_TOP      3328
#define XB_TOPGEN   3392
#define XCD_BAR_WORDS 3456
#define XB_SPIN_CAP (1u << 18)
__device__ __forceinline__ unsigned xb_ld(unsigned* p)              { return __hip_atomic_load(p, __ATOMIC_RELAXED, __HIP_MEMORY_SCOPE_AGENT); }
__device__ __forceinline__ unsigned xb_add(unsigned* p, unsigned v) { return __hip_atomic_fetch_add(p, v, __ATOMIC_RELAXED, __HIP_MEMORY_SCOPE_AGENT); }
__device__ __forceinline__ unsigned xb_xcc_id() { return (unsigned)__builtin_amdgcn_s_getreg((3 << 11) | 20) & 0xFu; }
#define XB_SPIN(cond, bar) do { unsigned _sp = 0; while (cond) { __builtin_amdgcn_s_sleep(1); \
    if ((++_sp & 255u) == 0u) { if (xb_ld(&(bar)[XB_TMO])) break; if (_sp > XB_SPIN_CAP) { atomicAdd(&(bar)[XB_TMO], 1u); break; } } } } while (0)
struct XcdBarrier { unsigned* bar; unsigned x; volatile LAS unsigned* st; };
__device__ __forceinline__ XcdBarrier xcd_barrier_post(unsigned* bar, volatile LAS unsigned* st) {
    XcdBarrier b; b.bar = bar; b.x = xb_xcc_id(); b.st = st;
    if (threadIdx.x == 0) (void)xb_add(&bar[XB_XCNT(b.x)], 1u);
    return b;
}
__device__ __forceinline__ void xcd_barrier_complete(unsigned* bar, unsigned x, unsigned& nloc, unsigned& nx) {
    const unsigned G = gridDim.x * gridDim.y * gridDim.z;
    unsigned sum, cnt, mine, sp = 0u;
    for (;;) {
        sum = 0u; cnt = 0u; mine = 0u;
#pragma unroll
        for (unsigned j = 0; j < 16; ++j) { const unsigned c = xb_ld(&bar[XB_XCNT(j)]); sum += c; cnt += (c > 0u) ? 1u : 0u; mine = (j == x) ? c : mine; }
        if (sum == G) break;
        __builtin_amdgcn_s_sleep(1);
        if ((++sp & 255u) == 0u) { if (xb_ld(&bar[XB_TMO])) break; if (sp > XB_SPIN_CAP) { atomicAdd(&bar[XB_TMO], 1u); break; } }
    }
    nloc = mine > 0u ? mine : 1u; nx = cnt > 0u ? cnt : 1u;
}
__device__ __forceinline__ void xcd_barrier(const XcdBarrier& b) {
    asm volatile("s_waitcnt vmcnt(0)" ::: "memory");
    __syncthreads();
    if (threadIdx.x == 0) {
        unsigned* bar = b.bar;
        __builtin_amdgcn_s_waitcnt(0);
        unsigned nloc = b.st[0], nx = b.st[1];
        if (nloc == 0u) { xcd_barrier_complete(bar, b.x, nloc, nx); b.st[0] = nloc; b.st[1] = nx; }
        const unsigned old = xb_add(&bar[XB_XSUB(b.x)], 1u);
        const unsigned gen = old / nloc;
        if (old + 1u == (gen + 1u) * nloc) {
            __builtin_amdgcn_fence(__ATOMIC_RELEASE, "agent");
            asm volatile("s_waitcnt vmcnt(0)" ::: "memory");
            const unsigned og = xb_add(&bar[XB_TOP], 1u);
            const unsigned tg = og / nx;
            if (og + 1u == (tg + 1u) * nx) xb_add(&bar[XB_TOPGEN], 1u);
            else XB_SPIN(xb_ld(&bar[XB_TOPGEN]) == tg, bar);
            __builtin_amdgcn_fence(__ATOMIC_ACQUIRE, "agent");
            xb_add(&bar[XB_XGEN(b.x)], 1u);
            asm volatile("s_waitcnt vmcnt(0)" ::: "memory");
        } else {
            XB_SPIN(xb_ld(&bar[XB_XGEN(b.x)]) == gen, bar);
            __builtin_amdgcn_fence(__ATOMIC_ACQUIRE, "agent");
            asm volatile("s_waitcnt vmcnt(0)" ::: "memory");
        }
    }
    __syncthreads();
}

__global__ void __launch_bounds__(512, 2) mega(P p) {
    extern __shared__ __attribute__((aligned(16))) unsigned char lds_raw[];
    LAS unsigned char* lds = (LAS unsigned char*)lds_raw;
    cg::grid_group grid = cg::this_grid();
    if (threadIdx.x < 4) ((volatile LAS unsigned*)(lds + LDS_STAGE))[threadIdx.x] = 0u;
    __syncthreads();
    { XcdBarrier xb0 = xcd_barrier_post((unsigned*)(p.ws + WS_BAR), (volatile LAS unsigned*)(lds + LDS_STAGE)); (void)xb0; }
    const int lo = p.ph_lo, hi = p.ph_hi, G = gridDim.x, bid = blockIdx.x;
#define B_MOD ((const float*)(p.ws + WS_MOD))
#define B_H ((bf16_t*)(p.ws + WS_H))
#define B_HID ((bf16_t*)(p.ws + WS_HID))
#define B_UG ((bf16_t*)(p.ws + WS_UG))
#define B_UGM ((bf16_t*)(p.ws + WS_UGM))
#define B_VG ((bf16_t*)(p.ws + WS_VG))
#define B_VT ((bf16_t*)(p.ws + WS_VT))
#define B_SLOC ((float*)(p.ws + WS_SLOC))
#define B_Y ((bf16_t*)(p.ws + WS_SLOC))
#define B_H2 ((bf16_t*)(p.ws + WS_H2))
#define B_RSS1 ((float*)(p.ws + WS_RSS1))
#define B_RSS2 ((float*)(p.ws + WS_RSS2))
#define B_RSSA ((float*)(p.ws + WS_RSSA))
#define B_RSSB ((float*)(p.ws + WS_RSSB))
#ifndef PHMASK
#define PHMASK 0xFFFF
#endif
#define IN(k) (((PHMASK >> (k)) & 1) && lo <= (k) && (k) < hi)
#define SYNC(k) do { if (IN(k) && IN((k) + 1)) { if (lo < 0) grid.sync(); else { unsigned char* w_ = p.ws; asm volatile("" : "+s"(w_)); XcdBarrier xb_; xb_.bar = (unsigned*)(w_ + WS_BAR); xb_.x = xb_xcc_id(); xb_.st = (volatile LAS unsigned*)(lds + LDS_STAGE); xcd_barrier(xb_); } } } while (0)
    if (IN(0)) phase0(p, lds);
    SYNC(0);
    if (IN(1)) { pass_modnorm_in(p, p.in[6], 0); fill_kmat(p);
        pass_shw(p, lds, (const bf16_t*)(p.ws + WS_WMIXIN), NMIX, 3, (float*)(p.ws + WS_SHW2)); pass_shw(p, lds, (const bf16_t*)(p.ws + WS_WIN2), NIN, 6, (float*)(p.ws + WS_SHW3)); }
    SYNC(1);
    if (IN(2)) { pg8::Gemm g{B_H, (const bf16_t*)(p.ws + WS_WIN1), DM, DM, DM, 0, 0, 0}; pg8::Order S; S.init(MT / 256, NIN / 256, 1, G, bid); EpiSwiglu<false> E{B_HID, nullptr, nullptr}; pg8::gemm_phase(lds, g, S, E); }
    SYNC(2);
    if (IN(3)) { pg8::Gemm g{B_HID, (const bf16_t*)(p.ws + WS_WOUT1), DFF, DFF, DFF, 0, 0, 0}; pg8::Order S; S.init(MT / 256, DM / 256, 1, G, bid);
        EpiResid<true, false, true> E{p.in[0], p.in[1], p.out, B_MOD + 2 * 1024, B_H, p.in[9], B_MOD + 4 * 1024, B_RSS1, nullptr, nullptr}; pg8::gemm_phase(lds, g, S, E); }
    SYNC(3);
    if (IN(4)) { pg8::Gemm g{B_H, (const bf16_t*)(p.ws + WS_WMIXIN), DM, DM, DM, 0, 0, 0}; pg8::Order S; S.init(MT / 256, NMIX / 256, 1, G, bid); EpiMixIn E{B_UG, B_UGM, B_VG, B_RSS1, (const float*)(p.ws + WS_SHW2)}; pg8::gemm_phase(lds, g, S, E); }
    SYNC(4);
    if (IN(5)) { pass_ln_transpose(p, lds);
        pg8::Gemm g{B_UG, (const bf16_t*)(p.ws + WS_W1S), KS2, 512, 512, (size_t)NCHK * KS2, (size_t)256 * 512, 0}; pg8::Order S; S.init(NCHK / 256, 1, NGRP, G, bid); EpiS1 E{B_SLOC}; pg8::gemm_phase(lds, g, S, E); }
    SYNC(5);
    if (IN(6)) { pass_chunk_scan(p);
        pg8::Gemm g{(const bf16_t*)(p.ws + WS_WBD), B_VT, 512, 512, 512, 0, 0, 0}; pg8::Order S; S.init(2, MT / 256, 1, G, bid); if (G == 256) { if (bid >= 64 && bid < 128) { S.c = 576 + (bid - 64); S.imax = 1; } else { S.G = 192; S.c = bid < 64 ? bid : bid - 64; S.imax = 3; } } EpiSpatial E{B_UGM, p.in[30], B_H, p.in[32], B_RSSB}; pg8::gemm_phase(lds, g, S, E); }
    SYNC(6);
    if (IN(7)) { pg8::Gemm g{B_UG, (const bf16_t*)(p.ws + WS_W2S), KS2, KS2, KS2, (size_t)NCHK * KS2, (size_t)512 * KS2, 0}; pg8::Order S; S.init(NCHK / 256, 2, NGRP, G, bid); EpiS2 E{B_Y}; pg8::gemm_phase(lds, g, S, E); }
    SYNC(7);
    if (IN(8)) { pg8::Gemm g{B_Y, (const bf16_t*)(p.ws + WS_WGLU), 512, 512, 512, 0, 0, 1}; pg8::Order S; S.init(MT / 256, 2, 1, G, bid); EpiGlu E{B_Y, B_H, p.in[31], B_RSSA}; pg8::gemm_phase(lds, g, S, E); }
    SYNC(8);
    if (IN(9)) { pg8::Gemm g{B_H, (const bf16_t*)(p.ws + WS_WMIXOUT), DM, DM, DM, 0, 0, 0}; pg8::Order S; S.init(MT / 256, DM / 256, 1, G, bid);
        EpiResid<true, true, false> E{p.out, p.out + (size_t)MP * DM, p.out, B_MOD + 5 * 1024, B_H2, p.in[34], B_MOD + 7 * 1024, B_RSS2, B_RSSA, B_RSSB}; pg8::gemm_phase(lds, g, S, E); }
    SYNC(9);
    if (IN(10)) { pg8::Gemm g{B_H2, (const bf16_t*)(p.ws + WS_WIN2), DM, DM, DM, 0, 0, 0}; pg8::Order S; S.init(MT / 256, NIN / 256, 1, G, bid); EpiSwiglu<true> E{B_HID, B_RSS2, (const float*)(p.ws + WS_SHW3)}; pg8::gemm_phase(lds, g, S, E); }
    SYNC(10);
    if (IN(11)) { pg8::Gemm g{B_HID, (const bf16_t*)(p.ws + WS_WOUT2), DFF, DFF, DFF, 0, 0, 0}; pg8::Order S; S.init(MT / 256, DM / 256, 1, G, bid);
        EpiResidFinal E{p.out, p.out, B_MOD + 8 * 1024, p.in[37], (float*)(p.ws + WS_RSS3), (unsigned*)(p.ws + WS_PCNT)}; pg8::gemm_phase(lds, g, S, E); }
#undef IN
#undef SYNC
}

extern "C" void kernel_launch(void* const* d_in, const int* in_sizes, int n_in, void* d_out, int out_size, void* d_ws, size_t ws_size, hipStream_t stream) {
    static int grid = 0;
    if (grid == 0) {
        if (n_in != 38 || out_size != MT * DM || ws_size < WS_END) { fprintf(stderr, "kernel_launch: unexpected shapes: n_in %d out %d ws %zu (need %zu)\n", n_in, out_size, ws_size, (size_t)WS_END); grid = -1; return; }
        int dev = 0, cus = 0, per_cu = 0;
        (void)hipGetDevice(&dev); (void)hipDeviceGetAttribute(&cus, hipDeviceAttributeMultiprocessorCount, dev);
        if (hipFuncSetAttribute((const void*)mega, hipFuncAttributeMaxDynamicSharedMemorySize, LDS_BYTES) != hipSuccess) { fprintf(stderr, "kernel_launch: hipFuncSetAttribute failed\n"); grid = -1; return; }
        (void)hipOccupancyMaxActiveBlocksPerMultiprocessor(&per_cu, (const void*)mega, 512, LDS_BYTES);
        if (per_cu < 1) per_cu = 1;
        grid = cus * 1;
        (void)hipGetLastError();
        fprintf(stderr, "kernel_launch: cus %d per_cu %d grid %d ws need %zu have %zu\n", cus, per_cu, grid, (size_t)WS_END, ws_size);
    }
    if (grid < 0) return;
    (void)hipMemsetAsync((char*)d_ws + WS_MOD, 0, ZERO_BYTES, stream);
    P p{};
    for (int i = 0; i < 38; ++i) p.in[i] = (const float*)d_in[i];
    p.out = (float*)d_out; p.ws = (unsigned char*)d_ws;
#if N_LAUNCH_MODE == 0
    p.ph_lo = 0; p.ph_hi = NPHASE;
    void* args[] = {&p};
    hipError_t e = hipLaunchCooperativeKernel((const void*)mega, dim3(grid), dim3(512), args, LDS_BYTES, stream);
    if (e != hipSuccess) fprintf(stderr, "cooperative launch failed: %s (grid %d)\n", hipGetErrorString(e), grid);
#else
    for (int k = 0; k < NPHASE; ++k) { p.ph_lo = k; p.ph_hi = k + 1; hipLaunchKernelGGL(mega, dim3(grid), dim3(512), LDS_BYTES, stream, p); }
#endif
}
```
